# Optimizing an MI355X kernel written in HIP

```python
import math
import jax, jax.numpy as jnp
from jax import lax
import numpy as np

D_MODEL = 1024
BATCH = 16
SEQ = 256
DEPTH = 2
DEC_BATCH = 2
DEC_SEQ = 2048
PAST_LEN = 512

GRID_W = 64
ROPE_BASE = 10000.0
QB = 128
CONV_W = 256
CONV_K = 3
DIFF_HEADS = 4
DIFF_DK = 32
DIFF_DV = 2 * DIFF_DK
DIFF_WIDTH = DIFF_HEADS * DIFF_DV
DIFF_QK_COLS = DIFF_HEADS * 2 * DIFF_DK
DIFF_SCALE = DIFF_DK ** -0.5
MLA_HEADS = 8
MLA_Q_RANK = 384
MLA_KV_RANK = 256
MLA_NOPE = 64
MLA_ROPE = 32
MLA_V = 64
MLA_QK = MLA_NOPE + MLA_ROPE
MLA_WIDTH = MLA_HEADS * MLA_V
MLA_SCALE = MLA_QK ** -0.5
MIX_WIDTH = CONV_W + DIFF_WIDTH + MLA_WIDTH
IN_SIZES = (CONV_W, CONV_W, CONV_W, DIFF_QK_COLS, DIFF_QK_COLS, DIFF_WIDTH, MLA_Q_RANK, MLA_KV_RANK, MLA_ROPE)
IN_COLS = 3 * CONV_W + 2 * DIFF_QK_COLS + DIFF_WIDTH + MLA_Q_RANK + MLA_KV_RANK + MLA_ROPE
D_FF = ((8 * D_MODEL // 3 + 255) // 256) * 256
DEEPNORM_ALPHA = (2 * DEPTH) ** 0.25
DEEPNORM_BETA = (8 * DEPTH) ** -0.25

kernel_name = "hybrid_diffusion_trunk_ctx_prefix_step"


def layer_norm(x, g, b, eps=1e-5):
    xf = x.astype(jnp.float32)
    mu = jnp.mean(xf, axis=-1, keepdims=True)
    var = jnp.mean(jnp.square(xf - mu), axis=-1, keepdims=True)
    return ((xf - mu) * lax.rsqrt(var + eps)).astype(x.dtype) * g + b


def rms_norm(x, w, eps=1e-6):
    xf = x.astype(jnp.float32)
    ms = jnp.mean(jnp.square(xf), axis=-1, keepdims=True)
    return (xf * lax.rsqrt(ms + eps)).astype(x.dtype) * w


def rope_1d(x, pos):
    half = x.shape[-1] // 2
    freqs = ROPE_BASE ** (-jnp.arange(half, dtype=jnp.float32) / half)
    ang = pos.astype(jnp.float32)[:, None] * freqs[None, :]
    cos = jnp.cos(ang).astype(x.dtype)
    sin = jnp.sin(ang).astype(x.dtype)
    x1, x2 = x[..., :half], x[..., half:]
    return jnp.concatenate([x1 * cos - x2 * sin, x1 * sin + x2 * cos], axis=-1)


def axial_rope(x, n_tokens):
    rows = n_tokens // GRID_W
    row = jnp.repeat(jnp.arange(rows), GRID_W)
    col = jnp.tile(jnp.arange(GRID_W), rows)
    h = x.shape[-1] // 2
    return jnp.concatenate([rope_1d(x[..., :h], row), rope_1d(x[..., h:], col)], axis=-1)


def map_query_blocks(fn, q):
    s = q.shape[-2]
    nb = s // QB
    qb = jnp.moveaxis(q.reshape(q.shape[:-2] + (nb, QB, q.shape[-1])), -3, 0)
    o = lax.map(fn, qb)
    o = jnp.moveaxis(o, 0, -3)
    return o.reshape(o.shape[:-3] + (s, o.shape[-1]))


def short_conv(u, w):
    up = jnp.pad(u, ((0, 0), (1, 1), (0, 0)))
    return up[:, :-2] * w[0] + up[:, 1:-1] * w[1] + up[:, 2:] * w[2]


def mixers(h, lp, lam, lam_init, ctx_cache):
    bsz, s, _ = h.shape
    offs = [int(o) for o in np.cumsum(IN_SIZES)[:-1]]
    proj = jnp.einsum("bsd,de->bse", h, lp["w_in"])
    a_x, a_b, a_c, d_q, d_k, d_v, m_cq, m_ckv, m_kpe = jnp.split(proj, offs, axis=-1)

    y_a = a_b * short_conv(a_c * a_x, lp["conv_w"])

    q = d_q.reshape(bsz, s, DIFF_HEADS, 2, DIFF_DK).transpose(0, 2, 3, 1, 4)
    k = d_k.reshape(bsz, s, DIFF_HEADS, 2, DIFF_DK).transpose(0, 2, 3, 1, 4)
    v = d_v.reshape(bsz, s, DIFF_HEADS, DIFF_DV).transpose(0, 2, 1, 3)

    cq = rms_norm(m_cq, lp["q_norm_w"])
    qc = jnp.einsum("bsr,re->bse", cq, lp["w_uq"]).reshape(bsz, s, MLA_HEADS, MLA_QK).transpose(0, 2, 1, 3)
    q_nope, q_pe = qc[..., :MLA_NOPE], qc[..., MLA_NOPE:]
    ckv = rms_norm(m_ckv, lp["kv_norm_w"])
    kpe = m_kpe

    if ctx_cache is None:
        new_ctx = (k, v, ckv, kpe)
        k_all, v_all, ckv_all, kpe_all = k, v, ckv, kpe
    else:
        q = axial_rope(q, s)
        k = axial_rope(k, s)
        q_pe = axial_rope(q_pe, s)
        kpe = axial_rope(kpe, s)
        ck, cv, cckv, ckpe = ctx_cache
        k_all = jnp.concatenate([k, ck], axis=3)
        v_all = jnp.concatenate([v, cv], axis=2)
        ckv_all = jnp.concatenate([ckv, cckv], axis=1)
        kpe_all = jnp.concatenate([kpe, ckpe], axis=1)
        new_ctx = None
    n_keys = ckv_all.shape[1]

    def diff_block(qb):
        sc = jnp.einsum("bhmqd,bhmkd->bhmqk", qb, k_all).astype(jnp.float32) * DIFF_SCALE
        p = jax.nn.softmax(sc, axis=-1)
        a = p[:, :, 0] - lam * p[:, :, 1]
        return jnp.einsum("bhqk,bhkd->bhqd", a.astype(v_all.dtype), v_all)

    o_b = map_query_blocks(diff_block, q)
    o_b = rms_norm(o_b, lp["diff_norm_w"]) * (1.0 - lam_init)
    y_b = o_b.transpose(0, 2, 1, 3).reshape(bsz, s, DIFF_WIDTH)

    kv = jnp.einsum("bnr,re->bne", ckv_all, lp["w_ukv"]).reshape(bsz, n_keys, MLA_HEADS, MLA_NOPE + MLA_V).transpose(0, 2, 1, 3)
    k_m = jnp.concatenate([kv[..., :MLA_NOPE], jnp.broadcast_to(kpe_all[:, None], (bsz, MLA_HEADS, n_keys, MLA_ROPE))], axis=-1)
    v_m = kv[..., MLA_NOPE:]
    q_m = jnp.concatenate([q_nope, q_pe], axis=-1)

    def mla_block(qb):
        sc = jnp.einsum("bhqd,bhkd->bhqk", qb, k_m).astype(jnp.float32) * MLA_SCALE
        p = jax.nn.softmax(sc, axis=-1)
        return jnp.einsum("bhqk,bhkd->bhqd", p.astype(v_m.dtype), v_m)

    o_c = map_query_blocks(mla_block, q_m)
    y_c = o_c.transpose(0, 2, 1, 3).reshape(bsz, s, MLA_WIDTH)

    y = jnp.einsum("bse,ed->bsd", jnp.concatenate([y_a, y_b, y_c], axis=-1), lp["w_out"])
    return y, new_ctx


def layer(x, cond, lp, layer_idx, ctx_cache):
    mod = jax.nn.silu(cond) @ lp["w_ada"] + lp["b_ada"]
    mod = mod.reshape((-1, 1, mod.shape[-1]))
    sh1, sc1, g1, sh2, sc2, g2 = jnp.split(mod, 6, axis=-1)
    lam_init = 0.8 - 0.6 * math.exp(-0.3 * layer_idx)
    lam = (jnp.exp(jnp.sum(lp["lam_q1"].astype(jnp.float32) * lp["lam_k1"].astype(jnp.float32)))
           - jnp.exp(jnp.sum(lp["lam_q2"].astype(jnp.float32) * lp["lam_k2"].astype(jnp.float32)))
           + lam_init)
    y, new_ctx = mixers(x * (1.0 + sc1) + sh1, lp, lam, lam_init, ctx_cache)
    x = layer_norm(DEEPNORM_ALPHA * x + g1 * y, lp["ln1_g"], lp["ln1_b"])
    hf = x * (1.0 + sc2) + sh2
    f = (jax.nn.silu(hf @ lp["w_ff1"]) * (hf @ lp["w_ff3"])) @ lp["w_ff2"]
    x = layer_norm(DEEPNORM_ALPHA * x + g2 * f, lp["ln2_g"], lp["ln2_b"])
    return x, new_ctx


def setup_inputs(seed: int = 0) -> dict:
    key = jax.random.key(seed)
    ks = jax.random.split(key, 32)
    f32 = jnp.float32
    L = DEPTH
    D = D_MODEL

    def nrm(k, shape, s):
        return jax.random.normal(k, shape, f32) * s

    return {
        "x_prompt": nrm(ks[0], (BATCH, SEQ, D), 1.0),
        "x_sample": nrm(ks[1], (DEC_BATCH, DEC_SEQ, D), 1.0),
        "cache_diff_k": nrm(ks[2], (DEC_BATCH, L, DIFF_HEADS, 2, PAST_LEN, DIFF_DK), 1.0),
        "cache_diff_v": nrm(ks[3], (DEC_BATCH, L, DIFF_HEADS, PAST_LEN, DIFF_DV), 1.0),
        "cache_mla_ckv": nrm(ks[4], (DEC_BATCH, L, PAST_LEN, MLA_KV_RANK), 1.0),
        "cache_mla_kpe": nrm(ks[5], (DEC_BATCH, L, PAST_LEN, MLA_ROPE), 1.0),
        "c": nrm(ks[6], (DEC_BATCH, D), 1.0),
        "c_ctx": nrm(ks[7], (D,), 1.0),
        "w_ada": nrm(ks[8], (L, D, 6 * D), D ** -0.5),
        "b_ada": nrm(ks[9], (L, 6 * D), 0.02),
        "w_in": nrm(ks[10], (L, D, IN_COLS), D ** -0.5),
        "conv_w": nrm(ks[11], (L, CONV_K, CONV_W), CONV_K ** -0.5),
        "lam_q1": nrm(ks[12], (L, DIFF_DK), 0.1),
        "lam_k1": nrm(ks[13], (L, DIFF_DK), 0.1),
        "lam_q2": nrm(ks[14], (L, DIFF_DK), 0.1),
        "lam_k2": nrm(ks[15], (L, DIFF_DK), 0.1),
        "diff_norm_w": 1.0 + nrm(ks[16], (L, DIFF_DV), 0.02),
        "q_norm_w": 1.0 + nrm(ks[17], (L, MLA_Q_RANK), 0.02),
        "w_uq": nrm(ks[18], (L, MLA_Q_RANK, MLA_HEADS * MLA_QK), MLA_Q_RANK ** -0.5),
        "kv_norm_w": 1.0 + nrm(ks[19], (L, MLA_KV_RANK), 0.02),
        "w_ukv": nrm(ks[20], (L, MLA_KV_RANK, MLA_HEADS * (MLA_NOPE + MLA_V)), MLA_KV_RANK ** -0.5),
        "w_out": nrm(ks[21], (L, MIX_WIDTH, D), MIX_WIDTH ** -0.5 * DEEPNORM_BETA),
        "ln1_g": 1.0 + nrm(ks[22], (L, D), 0.02),
        "ln1_b": nrm(ks[23], (L, D), 0.02),
        "w_ff1": nrm(ks[24], (L, D, D_FF), D ** -0.5),
        "w_ff3": nrm(ks[25], (L, D, D_FF), D ** -0.5),
        "w_ff2": nrm(ks[26], (L, D_FF, D), D_FF ** -0.5 * DEEPNORM_BETA),
        "ln2_g": 1.0 + nrm(ks[27], (L, D), 0.02),
        "ln2_b": nrm(ks[28], (L, D), 0.02),
    }


def reference(x_prompt, x_sample, cache_diff_k, cache_diff_v, cache_mla_ckv, cache_mla_kpe, c, c_ctx,
              w_ada, b_ada, w_in, conv_w, lam_q1, lam_k1, lam_q2, lam_k2, diff_norm_w, q_norm_w, w_uq,
              kv_norm_w, w_ukv, w_out, ln1_g, ln1_b, w_ff1, w_ff3, w_ff2, ln2_g, ln2_b):
    xp = x_prompt
    xs = x_sample
    st_k, st_v, st_ckv, st_kpe = [], [], [], []
    for l in range(DEPTH):
        lp = {
            "w_ada": w_ada[l], "b_ada": b_ada[l], "w_in": w_in[l], "conv_w": conv_w[l],
            "lam_q1": lam_q1[l], "lam_k1": lam_k1[l], "lam_q2": lam_q2[l], "lam_k2": lam_k2[l],
            "diff_norm_w": diff_norm_w[l], "q_norm_w": q_norm_w[l], "w_uq": w_uq[l],
            "kv_norm_w": kv_norm_w[l], "w_ukv": w_ukv[l], "w_out": w_out[l],
            "ln1_g": ln1_g[l], "ln1_b": ln1_b[l], "w_ff1": w_ff1[l], "w_ff3": w_ff3[l],
            "w_ff2": w_ff2[l], "ln2_g": ln2_g[l], "ln2_b": ln2_b[l],
        }
        xp, ctx = layer(xp, c_ctx, lp, l, None)
        st_k.append(ctx[0])
        st_v.append(ctx[1])
        st_ckv.append(ctx[2])
        st_kpe.append(ctx[3])
        cache_l = (cache_diff_k[:, l], cache_diff_v[:, l], cache_mla_ckv[:, l], cache_mla_kpe[:, l])
        xs, _ = layer(xs, c, lp, l, cache_l)
    state_diff_k = jnp.stack(st_k, axis=1)
    state_diff_v = jnp.stack(st_v, axis=1)
    state_mla_ckv = jnp.stack(st_ckv, axis=1)
    state_mla_kpe = jnp.stack(st_kpe, axis=1)
    return (xp, xs, state_diff_k, state_diff_v, state_mla_ckv, state_mla_kpe)
```

```cpp
#include <hip/hip_runtime.h>
#include <hip/hip_cooperative_groups.h>
#include <cstdio>
#include <cstdint>
namespace cg = cooperative_groups;

typedef unsigned short bf16_t;
typedef short bf16x8 __attribute__((ext_vector_type(8)));
typedef short s16x4 __attribute__((ext_vector_type(4)));
typedef float f32x16 __attribute__((ext_vector_type(16)));
typedef float f32x4 __attribute__((ext_vector_type(4)));
typedef float f32x2 __attribute__((ext_vector_type(2)));
typedef unsigned u32x4 __attribute__((ext_vector_type(4)));
typedef unsigned u32x2 __attribute__((ext_vector_type(2)));
typedef __bf16 bf2_t __attribute__((ext_vector_type(2)));

#ifndef REP_P0
#define REP_P0 1
#endif
#ifndef REP_P1
#define REP_P1 1
#endif
#ifndef REP_P2
#define REP_P2 1
#endif
#ifndef REP_P3
#define REP_P3 1
#endif
#ifndef REP_P6
#define REP_P6 1
#endif
#ifndef REP_SYNC
#define REP_SYNC 0
#endif
#define DI __device__ __forceinline__
#define MFMA(a, b, c) __builtin_amdgcn_mfma_f32_32x32x16_bf16((a), (b), (c), 0, 0, 0)

constexpr int NTOK = 8192, NPR = 4096, DM = 1024, INC = 2208, INP = 2304, DFF = 2816;
constexpr float LOG2E = 1.4426950408889634f;
constexpr float ALPHA = 1.4142135623730951f;
constexpr float QSC_DIFF = 0.17677669529663687f * LOG2E;
constexpr float QSC_MLA = 0.10206207261596575f * LOG2E;

constexpr size_t al(size_t x) { return (x + 255) & ~(size_t)255; }
constexpr size_t O_WIN = 0;
constexpr size_t O_WUQ = O_WIN + al(2ull * INP * 1024 * 2);
constexpr size_t O_WUKVN = O_WUQ + al(2ull * 768 * 384 * 2);
constexpr size_t O_WUKVC = O_WUKVN + al(2ull * 1024 * 256 * 2);
constexpr size_t O_WOUT = O_WUKVC + al(2ull * 1024 * 256 * 2);
constexpr size_t O_W13 = O_WOUT + al(2ull * 1024 * 1024 * 2);
constexpr size_t O_W2 = O_W13 + al(2ull * 5632 * 1024 * 2);
constexpr size_t O_H = O_W2 + al(2ull * 1024 * 2816 * 2);
constexpr size_t O_DKP = O_H + al(8192ull * 1024 * 2);
constexpr size_t N_DKS = 2ull * 4 * 2 * 2560 * 32;
constexpr size_t O_DKS = O_DKP + al(16ull * 4 * 2 * 256 * 32 * 2);
constexpr size_t O_DVTP = O_DKS + al(2 * N_DKS * 2);
constexpr size_t N_DVTS = 2ull * 4 * 64 * 2560;
constexpr size_t O_DVTS = O_DVTP + al(16ull * 4 * 64 * 256 * 2);
constexpr size_t O_KMP = O_DVTS + al(2 * N_DVTS * 2);
constexpr size_t N_KMS = 2ull * 8 * 2560 * 96;
constexpr size_t O_KMS = O_KMP + al(16ull * 8 * 256 * 96 * 2);
constexpr size_t O_VMTP = O_KMS + al(2 * N_KMS * 2);
constexpr size_t N_VMTS = 2ull * 8 * 64 * 2560;
constexpr size_t O_VMTS = O_VMTP + al(16ull * 8 * 64 * 256 * 2);
constexpr size_t O_CKVC = O_VMTS + al(2 * N_VMTS * 2);
constexpr size_t O_CKVF = O_CKVC + al(2ull * 2 * 512 * 256 * 2);
constexpr size_t O_XZ = O_CKVF + al(4096ull * 256 * 4);
constexpr size_t O_EXCH = O_XZ + al(8192ull * 1024 * 4);
constexpr size_t O_OWS = O_EXCH + al(4ull * 64 * 8 * 128 * 8);
constexpr size_t O_PART = O_OWS + al(2ull * 128 * 2 * 128 * 64 * 4);
constexpr size_t O_CTR = O_PART + al(2ull * 64 * 3 * 6144 * 4);
constexpr size_t O_BAR = O_CTR + 256;
constexpr size_t O_SSQ = O_BAR + al(3456 * 4);
constexpr size_t O_FLG = O_SSQ + al(2ull * 2 * 8192 * 4);
constexpr size_t O_MOD = O_FLG + al(4ull * 128 * 4);
constexpr size_t O_LNC = O_MOD + al(2ull * 3 * 6144 * 4);
constexpr size_t O_OVL = O_LNC + al(4ull * 64 * 64 * 4);
constexpr size_t O_AX = O_OVL;
constexpr size_t O_DQ = O_AX + al(8192ull * 768 * 2);
constexpr size_t O_CQ = O_DQ + al(8192ull * 256 * 2);
constexpr size_t O_CKVB = O_CQ + al(8192ull * 384 * 2);
constexpr size_t O_QM = O_CKVB + al(8192ull * 256 * 2);
constexpr size_t O_Y = O_QM + al(8192ull * 768 * 2);
constexpr size_t O_END1 = O_Y + al(8192ull * 1024 * 2);
constexpr size_t O_ACT = O_OVL;
constexpr size_t O_END2 = O_ACT + al(8192ull * 2816 * 2);
constexpr size_t WS_NEED = O_END1 > O_END2 ? O_END1 : O_END2;
static_assert(WS_NEED <= (256ull << 20), "workspace too large");

constexpr size_t OUT_Y = 0;
constexpr size_t OUT_SK = 8388608;
constexpr size_t OUT_SV = 10485760;
constexpr size_t OUT_CKV = 12582912;
constexpr size_t OUT_KPE = 14680064;

constexpr int SMEM_BYTES = 65536 + 4096;

struct Params {
  const float* x_prompt; const float* x_sample; const float* cache_k; const float* cache_v; const float* cache_ckv; const float* cache_kpe;
  const float* c; const float* c_ctx; const float* w_ada; const float* b_ada; const float* w_in; const float* conv_w;
  const float* lq1; const float* lk1; const float* lq2; const float* lk2; const float* diff_norm_w; const float* q_norm_w; const float* w_uq;
  const float* kv_norm_w; const float* w_ukv; const float* w_out; const float* ln1_g; const float* ln1_b; const float* w_ff1; const float* w_ff3;
  const float* w_ff2; const float* ln2_g; const float* ln2_b;
  float* out; char* ws;
};

DI int my_tid() { int t = threadIdx.x; asm volatile("" : "+v"(t)); return t; }
DI unsigned pack2(float lo, float hi) {
  f32x2 v = {lo, hi};
  bf2_t b = __builtin_convertvector(v, bf2_t);
  return __builtin_bit_cast(unsigned, b);
}
DI bf16_t f2bf(float x) { return (bf16_t)(pack2(x, 0.f) & 0xffffu); }
DI void st4bf(bf16_t* p, float a, float b, float c, float d) { u32x2 v = {pack2(a, b), pack2(c, d)}; *(u32x2*)p = v; }
DI void st_tile32_bf16(bf16_t* p0, int h, float v0, float v1, float v2, float v3, float v4, float v5, float v6, float v7,
                       float v8, float v9, float v10, float v11, float v12, float v13, float v14, float v15) {
  unsigned a0 = pack2(v0, v1), a1 = pack2(v2, v3), b0 = pack2(v4, v5), b1 = pack2(v6, v7);
  unsigned c0 = pack2(v8, v9), c1 = pack2(v10, v11), d0 = pack2(v12, v13), d1 = pack2(v14, v15);
  { auto r0 = __builtin_amdgcn_permlane32_swap(a0, b0, false, false); auto r1 = __builtin_amdgcn_permlane32_swap(a1, b1, false, false);
    u32x4 o = {r0[0], r1[0], r0[1], r1[1]}; *(u32x4*)(p0 + 8 * h) = o; }
  { auto r0 = __builtin_amdgcn_permlane32_swap(c0, d0, false, false); auto r1 = __builtin_amdgcn_permlane32_swap(c1, d1, false, false);
    u32x4 o = {r0[0], r1[0], r0[1], r1[1]}; *(u32x4*)(p0 + 16 + 8 * h) = o; }
}
#define ST_TILE32(P0, H, V, SC) st_tile32_bf16((P0), (H), (V)[0] * (SC), (V)[1] * (SC), (V)[2] * (SC), (V)[3] * (SC), (V)[4] * (SC), (V)[5] * (SC), (V)[6] * (SC), (V)[7] * (SC), \
    (V)[8] * (SC), (V)[9] * (SC), (V)[10] * (SC), (V)[11] * (SC), (V)[12] * (SC), (V)[13] * (SC), (V)[14] * (SC), (V)[15] * (SC))
DI float xor32_max(float x) { auto r = __builtin_amdgcn_permlane32_swap(__float_as_uint(x), __float_as_uint(x), false, false); return fmaxf(__uint_as_float(r[0]), __uint_as_float(r[1])); }
DI float xor32_sum(float x) { auto r = __builtin_amdgcn_permlane32_swap(__float_as_uint(x), __float_as_uint(x), false, false); return __uint_as_float(r[0]) + __uint_as_float(r[1]); }
DI float bf2f(bf16_t x) { return __uint_as_float(((unsigned)x) << 16); }

DI void rope16(f32x16& v, int s, int h) {
  const float pr = (float)(s >> 6), pc = (float)(s & 63);
#pragma unroll
  for (int i = 0; i < 4; ++i) {
    const float f = __builtin_amdgcn_exp2f(-1.6609640474436813f * (float)(4 * h + i));
    const float a1 = pr * f, a2 = pc * f;
    const float c1 = __cosf(a1), s1 = __sinf(a1), c2 = __cosf(a2), s2 = __sinf(a2);
    const float x1 = v[i], x2 = v[4 + i];
    v[i] = x1 * c1 - x2 * s1; v[4 + i] = x1 * s1 + x2 * c1;
    const float y1 = v[8 + i], y2 = v[12 + i];
    v[8 + i] = y1 * c2 - y2 * s2; v[12 + i] = y1 * s2 + y2 * c2;
  }
}

template <int SWAPMODE = 0, class Epi>
DI void gemm_tile(const bf16_t* __restrict__ A, int lda, const bf16_t* __restrict__ Bt, int ldb, int K, int m0, int n0, char* smem, const Epi& epi) {
  const int tid = my_tid(), lane = tid & 63, w = tid >> 6, wm = w & 1, wn = w >> 1, r = lane & 31, h = lane >> 5;
  constexpr bool swp = SWAPMODE == 1;
  f32x16 acc[2][2];
#pragma unroll
  for (int a = 0; a < 2; ++a)
#pragma unroll
    for (int b = 0; b < 2; ++b)
#pragma unroll
      for (int i = 0; i < 16; ++i) acc[a][b][i] = 0.f;
  const int srow = tid >> 3, sch = tid & 7;
  const bf16_t* ga = A + (size_t)(m0 + srow) * lda + sch * 8;
  const bf16_t* gb = Bt + (size_t)(n0 + srow) * ldb + sch * 8;
  const int swoff = srow * 128 + ((sch ^ ((srow >> 1) & 7)) << 4);
  u32x4 ra0[4], rb0[4], ra1[4], rb1[4];
  const int nk = K >> 6;
  const int sw = (r >> 1) & 7;
  const int arow = (wm * 64 + r) * 128, brow = 16384 + (wn * 64 + r) * 128;
#define G_LOAD(RA, RB, KT) do { _Pragma("unroll") for (int i = 0; i < 4; ++i) { RA[i] = *(const u32x4*)(ga + (size_t)(32 * i) * lda + (KT) * 64); RB[i] = *(const u32x4*)(gb + (size_t)(32 * i) * ldb + (KT) * 64); } } while (0)
#define S_WRITE(RA, RB, ST) do { _Pragma("unroll") for (int i = 0; i < 4; ++i) { *(u32x4*)(smem + (ST) * 32768 + swoff + i * 4096) = RA[i]; *(u32x4*)(smem + (ST) * 32768 + 16384 + swoff + i * 4096) = RB[i]; } } while (0)
#define G_FRAGS(ST, KK, FA, FB) do { const int co_ = (((KK) * 2 + h) ^ sw) << 4; \
    _Pragma("unroll") for (int mi = 0; mi < 2; ++mi) FA[mi] = *(const bf16x8*)(smem + (ST) * 32768 + arow + mi * 4096 + co_); \
    _Pragma("unroll") for (int ni = 0; ni < 2; ++ni) FB[ni] = *(const bf16x8*)(smem + (ST) * 32768 + brow + ni * 4096 + co_); } while (0)
#define G_MMA(FA, FB) do { if (SWAPMODE != 0 && swp) { _Pragma("unroll") for (int mi = 0; mi < 2; ++mi) _Pragma("unroll") for (int ni = 0; ni < 2; ++ni) acc[mi][ni] = MFMA(FA[mi], FB[ni], acc[mi][ni]); } \
    else { _Pragma("unroll") for (int mi = 0; mi < 2; ++mi) _Pragma("unroll") for (int ni = 0; ni < 2; ++ni) acc[mi][ni] = MFMA(FB[ni], FA[mi], acc[mi][ni]); } } while (0)
#define G_COMPUTE(ST) do { bf16x8 fa0[2], fb0[2], fa1[2], fb1[2]; \
    G_FRAGS(ST, 0, fa0, fb0); \
    G_FRAGS(ST, 1, fa1, fb1); __builtin_amdgcn_sched_barrier(0); \
    G_MMA(fa0, fb0); __builtin_amdgcn_sched_barrier(0); \
    G_FRAGS(ST, 2, fa0, fb0); __builtin_amdgcn_sched_barrier(0); \
    G_MMA(fa1, fb1); __builtin_amdgcn_sched_barrier(0); \
    G_FRAGS(ST, 3, fa1, fb1); __builtin_amdgcn_sched_barrier(0); \
    G_MMA(fa0, fb0); __builtin_amdgcn_sched_barrier(0); \
    G_MMA(fa1, fb1); } while (0)
  G_LOAD(ra0, rb0, 0);
  G_LOAD(ra1, rb1, 1);
  S_WRITE(ra0, rb0, 0);
  __syncthreads();
  for (int kt = 0; kt < nk; kt += 2) {
    G_LOAD(ra0, rb0, (kt + 2 < nk ? kt + 2 : nk - 1));
    G_COMPUTE(0);
    S_WRITE(ra1, rb1, 1);
    __syncthreads();
    G_LOAD(ra1, rb1, (kt + 3 < nk ? kt + 3 : nk - 1));
    G_COMPUTE(1);
    S_WRITE(ra0, rb0, 0);
    __syncthreads();
  }
#undef G_LOAD
#undef S_WRITE
#undef G_COMPUTE
#undef G_FRAGS
#undef G_MMA
  epi(acc, m0 + wm * 64, n0 + wn * 64, r, h);
}


template <class Epi>
DI void gemm_tile_bd(const bf16_t* __restrict__ A, int lda, const bf16_t* __restrict__ Bf, int K, int m0, int n0, char* smem, const Epi& epi) {
  const int tid = my_tid(), lane = tid & 63, w = tid >> 6, wm = w & 1, wn = w >> 1, r = lane & 31, h = lane >> 5;
  f32x16 acc[2][2];
#pragma unroll
  for (int a = 0; a < 2; ++a)
#pragma unroll
    for (int b = 0; b < 2; ++b)
#pragma unroll
      for (int i = 0; i < 16; ++i) acc[a][b][i] = 0.f;
  const int srow = tid >> 3, sch = tid & 7;
  const bf16_t* ga = A + (size_t)(m0 + srow) * lda + sch * 8;
  const int swoff = srow * 128 + ((sch ^ ((srow >> 1) & 7)) << 4);
  const int k16 = K >> 4;
  const bf16_t* gb0 = Bf + ((size_t)(((n0 + wn * 64) >> 5) + 0) * k16 * 64 + lane) * 8;
  const bf16_t* gb1 = Bf + ((size_t)(((n0 + wn * 64) >> 5) + 1) * k16 * 64 + lane) * 8;
  u32x4 ra0[4], ra1[4];
  bf16x8 bq0[2][4], bq1[2][4];
  const int nk = K >> 6;
  const int sw = (r >> 1) & 7;
  const int arow = (wm * 64 + r) * 128;
#define GA_LOAD(RA, KT) do { _Pragma("unroll") for (int i = 0; i < 4; ++i) RA[i] = *(const u32x4*)(ga + (size_t)(32 * i) * lda + (KT) * 64); } while (0)
#define GB_LOAD(BQ, KT) do { _Pragma("unroll") for (int kk = 0; kk < 4; ++kk) { BQ[0][kk] = *(const bf16x8*)(gb0 + (size_t)((KT) * 4 + kk) * 512); BQ[1][kk] = *(const bf16x8*)(gb1 + (size_t)((KT) * 4 + kk) * 512); } } while (0)
#define SA_WRITE(RA, ST) do { _Pragma("unroll") for (int i = 0; i < 4; ++i) *(u32x4*)(smem + (ST) * 16384 + swoff + i * 4096) = RA[i]; } while (0)
#define GBD_COMPUTE(ST, BQ) do { _Pragma("unroll") for (int kk = 0; kk < 4; ++kk) { const int co = ((kk * 2 + h) ^ sw) << 4; bf16x8 fa[2]; \
    _Pragma("unroll") for (int mi = 0; mi < 2; ++mi) fa[mi] = *(const bf16x8*)(smem + (ST) * 16384 + arow + mi * 4096 + co); \
    _Pragma("unroll") for (int mi = 0; mi < 2; ++mi) _Pragma("unroll") for (int ni = 0; ni < 2; ++ni) acc[mi][ni] = MFMA(BQ[ni][kk], fa[mi], acc[mi][ni]); } } while (0)
  GA_LOAD(ra0, 0);
  GA_LOAD(ra1, 1);
  GB_LOAD(bq0, 0);
  SA_WRITE(ra0, 0);
  __syncthreads();
  for (int kt = 0; kt < nk; kt += 2) {
    GB_LOAD(bq1, kt + 1);
    if (kt + 2 < nk) GA_LOAD(ra0, kt + 2);
    GBD_COMPUTE(0, bq0);
    SA_WRITE(ra1, 1);
    __syncthreads();
    if (kt + 2 < nk) GB_LOAD(bq0, kt + 2);
    if (kt + 3 < nk) GA_LOAD(ra1, kt + 3);
    GBD_COMPUTE(1, bq1);
    if (kt + 2 < nk) SA_WRITE(ra0, 0);
    __syncthreads();
  }
#undef GA_LOAD
#undef GB_LOAD
#undef SA_WRITE
#undef GBD_COMPUTE
  epi(acc, m0 + wm * 64, n0 + wn * 64, r, h);
}

DI void row_rms(const bf16_t* __restrict__ A, int lda, int K, int m0, float* rs) {
  const int tid = my_tid(), row = tid >> 1, half = tid & 1;
  const bf16_t* p = A + (size_t)(m0 + row) * lda + half * (K >> 1);
  float s = 0.f;
  for (int k = 0; k < (K >> 1); k += 8) {
    u32x4 v = *(const u32x4*)(p + k);
#pragma unroll
    for (int j = 0; j < 4; ++j) { float a = __uint_as_float(v[j] << 16), b = __uint_as_float(v[j] & 0xffff0000u); s += a * a + b * b; }
  }
  s += __shfl_xor(s, 1);
  if (half == 0) rs[row] = rsqrtf(s / (float)K + 1e-6f);
}

DI void tok_decode(int T, bool& smp, int& b, int& s) {
  smp = T >= NPR;
  if (!smp) { b = T >> 8; s = T & 255; } else { const int t2 = T - NPR; b = t2 >> 11; s = t2 & 2047; }
}

template <int MASK> struct EpiInT {
  int l; bf16_t *AX, *DQ, *DKP, *DKS, *DVTP, *DVTS, *CQ, *CKVB, *KMP, *KMS; float* CKVF; float* out; float* SSQ;
  DI void operator()(f32x16 (&acc)[2][2], int tb, int nb, int r, int h) const {
#pragma unroll
    for (int mi = 0; mi < 2; ++mi) {
      const int T = tb + mi * 32 + r; bool smp; int b, s; tok_decode(T, smp, b, s);
#pragma unroll
      for (int ni = 0; ni < 2; ++ni) {
        const int nt = nb + ni * 32; f32x16 v = acc[mi][ni];
        if (nt < 768) { if (MASK & 1) {
          ST_TILE32(AX + (size_t)T * 768 + nt, h, v, 1.f);
        } } else if (nt < 1024) { if (MASK & 2) {
          const int c = nt - 768, hd = c >> 6, mp = (c >> 5) & 1;
          if (smp) rope16(v, s, h);
          const size_t base = smp ? (size_t)NPR * 256 + ((((size_t)b * 4 + hd) * 2 + mp) * 2048 + s) * 32 : ((((size_t)b * 4 + hd) * 2 + mp) * 256 + s) * 32;
          ST_TILE32(DQ + base, h, v, QSC_DIFF);
        } } else if (nt < 1280) { if (MASK & 2) {
          const int c = nt - 1024, hd = c >> 6, mp = (c >> 5) & 1;
          if (!smp) {
            float* o = out + OUT_SK + ((((((size_t)b * 2 + l) * 4 + hd) * 2 + mp) * 256 + s) * 32) + 4 * h;
            bf16_t* d = DKP + ((((size_t)b * 4 + hd) * 2 + mp) * 256 + s) * 32 + 4 * h;
#pragma unroll
            for (int g = 0; g < 4; ++g) { f32x4 t = {v[4 * g], v[4 * g + 1], v[4 * g + 2], v[4 * g + 3]}; *(f32x4*)(o + 8 * g) = t; }
            ST_TILE32(d - 4 * h, h, v, 1.f);
          } else {
            rope16(v, s, h);
            ST_TILE32(DKS + ((((size_t)b * 4 + hd) * 2 + mp) * 2560 + s) * 32, h, v, 1.f);
          }
        } } else if (nt < 1536) { if (MASK & 4) {
          const int c = nt - 1280, hd = c >> 6, dvb = c & 63;
          if (!smp) {
            float* o = out + OUT_SV + (((((size_t)b * 2 + l) * 4 + hd) * 256 + s) * 64) + dvb + 4 * h;
            bf16_t* d = DVTP + (((size_t)b * 4 + hd) * 64 + dvb + 4 * h) * 256 + s;
#pragma unroll
            for (int g = 0; g < 4; ++g) {
              f32x4 t = {v[4 * g], v[4 * g + 1], v[4 * g + 2], v[4 * g + 3]}; *(f32x4*)(o + 8 * g) = t;
#pragma unroll
              for (int j = 0; j < 4; ++j) d[(size_t)(8 * g + j) * 256] = f2bf(t[j]);
            }
          } else {
            bf16_t* d = DVTS + (((size_t)b * 4 + hd) * 64 + dvb + 4 * h) * 2560 + s;
#pragma unroll
            for (int g = 0; g < 4; ++g)
#pragma unroll
              for (int j = 0; j < 4; ++j) d[(size_t)(8 * g + j) * 2560] = f2bf(v[4 * g + j]);
          }
        } } else if (nt < 1920) { if (MASK & 1) {
          ST_TILE32(CQ + (size_t)T * 384 + (nt - 1536), h, v, 1.f);
          { float sq = 0.f;
#pragma unroll
            for (int i = 0; i < 16; ++i) sq += v[i] * v[i];
            sq = xor32_sum(sq);
            if (h == 0) atomicAdd(SSQ + T, sq); }
        } } else if (nt < 2176) { if (MASK & 8) {
          ST_TILE32(CKVB + (size_t)T * 256 + (nt - 1920), h, v, 1.f);
          { float sq = 0.f;
#pragma unroll
            for (int i = 0; i < 16; ++i) sq += v[i] * v[i];
            sq = xor32_sum(sq);
            if (h == 0) atomicAdd(SSQ + 8192 + T, sq); }
          if (!smp) {
            float* o = CKVF + (size_t)T * 256 + (nt - 1920) + 4 * h;
#pragma unroll
            for (int g = 0; g < 4; ++g) { f32x4 t = {v[4 * g], v[4 * g + 1], v[4 * g + 2], v[4 * g + 3]}; *(f32x4*)(o + 8 * g) = t; }
          }
        } } else if (nt < 2208) { if (MASK & 16) {
          if (!smp) {
            float* o = out + OUT_KPE + (((size_t)b * 2 + l) * 256 + s) * 32 + 4 * h;
#pragma unroll
            for (int g = 0; g < 4; ++g) { f32x4 t = {v[4 * g], v[4 * g + 1], v[4 * g + 2], v[4 * g + 3]}; *(f32x4*)(o + 8 * g) = t; }
            for (int hh = 0; hh < 8; ++hh) {
              ST_TILE32(KMP + (((size_t)b * 8 + hh) * 256 + s) * 96 + 64, h, v, 1.f);
            }
          } else {
            rope16(v, s, h);
            for (int hh = 0; hh < 8; ++hh) {
              ST_TILE32(KMS + (((size_t)b * 8 + hh) * 2560 + s) * 96 + 64, h, v, 1.f);
            }
          }
        } }
      }
    }
  }
};
typedef EpiInT<31> EpiIn;

struct EpiNull { float* sink;
  DI void operator()(f32x16 (&acc)[2][2], int tb, int nb, int r, int h) const {
    float s = 0.f;
#pragma unroll
    for (int a = 0; a < 2; ++a)
#pragma unroll
      for (int b = 0; b < 2; ++b)
#pragma unroll
        for (int i = 0; i < 16; ++i) s += acc[a][b][i];
    if (s == 12345.678f) sink[tb + r] = s;
  }
};
struct EpiUq {
  bf16_t* QM; const float* ssq;
  DI void operator()(f32x16 (&acc)[2][2], int tb, int nb, int r, int h) const {
#pragma unroll
    for (int mi = 0; mi < 2; ++mi) {
      const int T = tb + mi * 32 + r; bool smp; int b, s; tok_decode(T, smp, b, s);
      const float sc = rsqrtf(ssq[T] * (1.f / 384.f) + 1e-6f) * QSC_MLA;
#pragma unroll
      for (int ni = 0; ni < 2; ++ni) {
        const int nt = nb + ni * 32; f32x16 v = acc[mi][ni];
        const int hh = nt / 96, dd0 = nt - hh * 96;
        if (dd0 == 64 && smp) rope16(v, s, h);
        const size_t base = smp ? (size_t)NPR * 768 + (((size_t)b * 8 + hh) * 2048 + s) * 96 : (((size_t)b * 8 + hh) * 256 + s) * 96;
        ST_TILE32(QM + base + dd0, h, v, sc);
      }
    }
  }
};

struct EpiUkv {
  int mode; bf16_t *KMP, *VMTP, *KMS, *VMTS;   const float* ssq;
  DI void operator()(f32x16 (&acc)[2][2], int tb, int nb, int r, int h) const {
    if (__builtin_amdgcn_readfirstlane(nb & 64)) {
#pragma unroll
      for (int mi = 0; mi < 2; ++mi) {
        const int R0 = __builtin_amdgcn_readfirstlane(tb) + mi * 32;
        bf16_t* vmt; int b, s0, S_all;
        if (mode == 0) {
          bool smp; tok_decode(R0, smp, b, s0);
          if (smp) { vmt = VMTS; S_all = 2560; } else { vmt = VMTP; S_all = 256; }
#pragma unroll
          for (int g = 0; g < 4; ++g) {
            const f32x4 q = *(const f32x4*)(ssq + R0 + 8 * g + 4 * h);
#pragma unroll
            for (int j = 0; j < 4; ++j) {
              const float sj = rsqrtf(q[j] * (1.f / 256.f) + 1e-6f);
              acc[mi][0][4 * g + j] *= sj; acc[mi][1][4 * g + j] *= sj;
            }
          }
        } else {
          const int lc = R0 >> 10; b = (R0 >> 9) & 1; s0 = 2048 + (R0 & 511);
          vmt = VMTS + (size_t)lc * N_VMTS; S_all = 2560;
        }
#pragma unroll
        for (int ni = 0; ni < 2; ++ni) {
          const int nt = nb + ni * 32, hh = nt >> 7, dv = (nt & 127) - 64 + r;
          ST_TILE32(vmt + (((size_t)b * 8 + hh) * 64 + dv) * S_all + s0, h, acc[mi][ni], 1.f);
        }
      }
      return;
    }
#pragma unroll
    for (int mi = 0; mi < 2; ++mi) {
      const int R = tb + mi * 32 + r;
      bf16_t *km, *vmt; int b, s, S_all; float sc;
      if (mode == 0) {
        bool smp; tok_decode(R, smp, b, s); sc = rsqrtf(ssq[R] * (1.f / 256.f) + 1e-6f);
        if (smp) { km = KMS; vmt = VMTS; S_all = 2560; } else { km = KMP; vmt = VMTP; S_all = 256; }
      } else {
        const int lc = R >> 10; b = (R >> 9) & 1; s = 2048 + (R & 511); sc = 1.f;
        km = KMS + (size_t)lc * N_KMS; vmt = VMTS + (size_t)lc * N_VMTS; S_all = 2560;
      }
#pragma unroll
      for (int ni = 0; ni < 2; ++ni) {
        const int nt = nb + ni * 32; const f32x16 v = acc[mi][ni];
        const int hh = nt >> 7, e0 = nt & 127;
        if (e0 < 64) {
          ST_TILE32(km + (((size_t)b * 8 + hh) * S_all + s) * 96 + e0, h, v, sc);
        } else {
          bf16_t* d = vmt + (((size_t)b * 8 + hh) * 64 + (e0 - 64) + 4 * h) * S_all + s;
#pragma unroll
          for (int g = 0; g < 4; ++g)
#pragma unroll
            for (int j = 0; j < 4; ++j) d[(size_t)(8 * g + j) * S_all] = f2bf(v[4 * g + j] * sc);
        }
      }
    }
  }
};

struct EpiRes {
  const float* xp; const float* xs; float* xz; const float* gate;
  DI void operator()(f32x16 (&acc)[2][2], int tb, int nb, int r, int h) const {
#pragma unroll
    for (int mi = 0; mi < 2; ++mi) {
      const int T = tb + mi * 32 + r;
      const int vi = T < NPR ? 0 : 1 + ((T - NPR) >> 11);
      const float* xr = T < NPR ? xp + (size_t)T * 1024 : xs + (size_t)(T - NPR) * 1024;
      const float* gp = gate + vi * 6144;
      float* zo = xz + (size_t)T * 1024;
#pragma unroll
      for (int ni = 0; ni < 2; ++ni) {
        const f32x16 v = acc[mi][ni];
#pragma unroll
        for (int g = 0; g < 4; ++g) {
          const int n = nb + ni * 32 + 8 * g + 4 * h;
          const f32x4 x = *(const f32x4*)(xr + n), gg = *(const f32x4*)(gp + n);
          f32x4 z = {ALPHA * x[0] + gg[0] * v[4 * g], ALPHA * x[1] + gg[1] * v[4 * g + 1], ALPHA * x[2] + gg[2] * v[4 * g + 2], ALPHA * x[3] + gg[3] * v[4 * g + 3]};
          *(f32x4*)(zo + n) = z;
        }
      }
    }
  }
};


struct EpiResLN {
  const float* xp; const float* xs; float* xout; bf16_t* Hout; const float* gate; const float* lng; const float* lnb; const float* modsh;
  unsigned long long* exch; unsigned* cnt; char* smem; int mt, nt;
  DI void operator()(f32x16 (&acc)[2][2], int tb, int nb, int r, int h) const {
    const int tid = my_tid();
    float* part = (float*)(smem + 65536);
    float* stat = (float*)(smem + 65536 + 2048);
    const int wm = (tb >> 6) & 1, wn = (nb >> 6) & 1;
    const int vi_t = tb < NPR ? 0 : 1 + ((tb - NPR) >> 11);
    {
      f32x4 gg[2][4];
      const float* gp = gate + vi_t * 6144 + nb + 4 * h;
#pragma unroll
      for (int ni = 0; ni < 2; ++ni)
#pragma unroll
        for (int g = 0; g < 4; ++g) gg[ni][g] = *(const f32x4*)(gp + ni * 32 + 8 * g);
#pragma unroll
      for (int mi = 0; mi < 2; ++mi) {
        const int T = tb + mi * 32 + r;
        const float* xr = (T < NPR ? xp + (size_t)T * 1024 : xs + (size_t)(T - NPR) * 1024) + nb + 4 * h;
        f32x4 xv[2][4];
#pragma unroll
        for (int ni = 0; ni < 2; ++ni)
#pragma unroll
          for (int g = 0; g < 4; ++g) xv[ni][g] = *(const f32x4*)(xr + ni * 32 + 8 * g);
        float s1 = 0.f, s2 = 0.f;
#pragma unroll
        for (int ni = 0; ni < 2; ++ni)
#pragma unroll
          for (int g = 0; g < 4; ++g)
#pragma unroll
            for (int j = 0; j < 4; ++j) { const float z = ALPHA * xv[ni][g][j] + gg[ni][g][j] * acc[mi][ni][4 * g + j]; acc[mi][ni][4 * g + j] = z; s1 += z; s2 += z * z; }
        s1 = xor32_sum(s1); s2 = xor32_sum(s2);
        if (h == 0) { const int row = wm * 64 + mi * 32 + r; part[(wn * 128 + row) * 2] = s1; part[(wn * 128 + row) * 2 + 1] = s2; }
      }
    }
    __syncthreads();
    if (tid < 128) {
      const float a = part[tid * 2] + part[(128 + tid) * 2], b = part[tid * 2 + 1] + part[(128 + tid) * 2 + 1];
      const unsigned long long pk = ((unsigned long long)__float_as_uint(b) << 32) | (unsigned long long)__float_as_uint(a);
      __hip_atomic_store(exch + ((size_t)mt * 8 + nt) * 128 + tid, pk, __ATOMIC_RELAXED, __HIP_MEMORY_SCOPE_AGENT);
    }
    asm volatile("s_waitcnt vmcnt(0)" ::: "memory");
    __syncthreads();
    if (tid == 0) {
      __hip_atomic_fetch_add(cnt + 64 * mt, 1u, __ATOMIC_RELAXED, __HIP_MEMORY_SCOPE_AGENT);
      unsigned sp = 0;
      while (__hip_atomic_load(cnt + 64 * mt, __ATOMIC_RELAXED, __HIP_MEMORY_SCOPE_AGENT) < 8u) { __builtin_amdgcn_s_sleep(1); if (++sp > (1u << 22)) break; }
    }
    __syncthreads();
    if (tid < 128) {
      float a = 0.f, b = 0.f;
#pragma unroll
      for (int q = 0; q < 8; ++q) {
        const unsigned long long pk = __hip_atomic_load(exch + ((size_t)mt * 8 + q) * 128 + tid, __ATOMIC_RELAXED, __HIP_MEMORY_SCOPE_AGENT);
        a += __uint_as_float((unsigned)pk); b += __uint_as_float((unsigned)(pk >> 32));
      }
      const float mean = a * (1.f / 1024.f);
      const float var = fmaxf(b * (1.f / 1024.f) - mean * mean, 0.f);
      stat[tid * 2] = mean; stat[tid * 2 + 1] = rsqrtf(var + 1e-5f);
    }
    __syncthreads();
    {
      const float* mp = modsh + vi_t * 6144 + nb + 4 * h;
      float mean[2], rstd[2];
#pragma unroll
      for (int mi = 0; mi < 2; ++mi) { const int row = wm * 64 + mi * 32 + r; mean[mi] = stat[row * 2]; rstd[mi] = stat[row * 2 + 1]; }
#pragma unroll
      for (int ni = 0; ni < 2; ++ni) {
        f32x4 gg[4], bv[4], sh[4], sc[4];
#pragma unroll
        for (int g = 0; g < 4; ++g) {
          gg[g] = *(const f32x4*)(lng + nb + 4 * h + ni * 32 + 8 * g); bv[g] = *(const f32x4*)(lnb + nb + 4 * h + ni * 32 + 8 * g);
          if (Hout) { sh[g] = *(const f32x4*)(mp + ni * 32 + 8 * g); sc[g] = *(const f32x4*)(mp + 1024 + ni * 32 + 8 * g); }
        }
#pragma unroll
        for (int mi = 0; mi < 2; ++mi) {
          const int T = tb + mi * 32 + r;
          float hv[16];
#pragma unroll
          for (int g = 0; g < 4; ++g) {
            const int n = nb + ni * 32 + 8 * g + 4 * h;
            f32x4 x;
#pragma unroll
            for (int j = 0; j < 4; ++j) x[j] = (acc[mi][ni][4 * g + j] - mean[mi]) * rstd[mi] * gg[g][j] + bv[g][j];
            *(f32x4*)(xout + (size_t)T * 1024 + n) = x;
            if (Hout) {
#pragma unroll
              for (int j = 0; j < 4; ++j) hv[4 * g + j] = x[j] * (sc[g][j] + 1.f) + sh[g][j];
            }
          }
          if (Hout) ST_TILE32(Hout + (size_t)T * 1024 + nb + ni * 32, h, hv, 1.f);
        }
      }
    }
  }
};

struct EpiFfUp {
  bf16_t* ACT;
  DI void operator()(f32x16 (&acc)[2][2], int tb, int nb, int r, int h) const {
#pragma unroll
    for (int mi = 0; mi < 2; ++mi) {
      const int T = tb + mi * 32 + r;
      float o[16];
#pragma unroll
      for (int i = 0; i < 16; ++i) { const float ga = acc[mi][0][i], up = acc[mi][1][i]; o[i] = ga * up * __builtin_amdgcn_rcpf(1.f + __builtin_amdgcn_exp2f(-LOG2E * ga)); }
      ST_TILE32(ACT + (size_t)T * DFF + (nb >> 1), h, o, 1.f);
    }
  }
};

template <bool LN>
DI void ln_mod_pass(const float* sp, const float* ss, float* xdst, bf16_t* hdst, const float* g, const float* bb, const float* mod_sh  ) {
  const int tid_ = my_tid(); const int lane = tid_ & 63, w = tid_ >> 6;
  for (int T = blockIdx.x * 4 + w; T < NTOK; T += gridDim.x * 4) {
    const float* src = T < NPR ? sp + (size_t)T * 1024 : ss + (size_t)(T - NPR) * 1024;
    f32x4 v[4];
#pragma unroll
    for (int i = 0; i < 4; ++i) v[i] = *(const f32x4*)(src + lane * 4 + 256 * i);
    if (LN) {
      float s = 0.f;
#pragma unroll
      for (int i = 0; i < 4; ++i) s += (v[i][0] + v[i][1]) + (v[i][2] + v[i][3]);
#pragma unroll
      for (int o = 32; o >= 1; o >>= 1) s += __shfl_xor(s, o);
      const float mu = s * (1.f / 1024.f);
      float q = 0.f;
#pragma unroll
      for (int i = 0; i < 4; ++i) { v[i] = v[i] - mu; q += (v[i][0] * v[i][0] + v[i][1] * v[i][1]) + (v[i][2] * v[i][2] + v[i][3] * v[i][3]); }
#pragma unroll
      for (int o = 32; o >= 1; o >>= 1) q += __shfl_xor(q, o);
      const float rstd = rsqrtf(q * (1.f / 1024.f) + 1e-5f);
#pragma unroll
      for (int i = 0; i < 4; ++i) {
        const f32x4 gg = *(const f32x4*)(g + lane * 4 + 256 * i), bv = *(const f32x4*)(bb + lane * 4 + 256 * i);
        v[i] = v[i] * rstd * gg + bv;
        *(f32x4*)(xdst + (size_t)T * 1024 + lane * 4 + 256 * i) = v[i];
      }
    }
    if (hdst) {
      const int vi = T < NPR ? 0 : 1 + ((T - NPR) >> 11);
      const float* mp = mod_sh + vi * 6144;
#pragma unroll
      for (int i = 0; i < 4; ++i) {
        const f32x4 sh = *(const f32x4*)(mp + lane * 4 + 256 * i), sc = *(const f32x4*)(mp + 1024 + lane * 4 + 256 * i);
        const f32x4 o = v[i] * (sc + 1.f) + sh;
        st4bf(hdst + (size_t)T * 1024 + lane * 4 + 256 * i, o[0], o[1], o[2], o[3]);
      }
    }
  }
}

template <int MODE>
DI void attn_unit(const bf16_t* __restrict__ Q, size_t qmap, const bf16_t* __restrict__ Kg, size_t kmap, const bf16_t* __restrict__ VT, int S_all, int nkeys,
                  bf16_t* __restrict__ Yout, float lam, const float* __restrict__ normw, float oscale, char* smem,
                  float* ows_pair, unsigned* flag, int mapidx, int* s_flag) {
  constexpr bool DIFF = MODE == 1, D32 = MODE != 0;
  constexpr int DQK = D32 ? 32 : 96, NKS = DQK / 16, NMAP = DIFF ? 2 : 1, KROWB = D32 ? 80 : 208;
  constexpr int KREG = NMAP * 64 * KROWB, STAGE = 24576, KCH = DQK / 8  , NKLD = NMAP * 64 * KCH / 256;
  const int tid = my_tid(), lane = tid & 63, w = tid >> 6, r = lane & 31, h = lane >> 5;
  bf16x8 qf[NMAP][NKS];
#pragma unroll
  for (int m = 0; m < NMAP; ++m)
#pragma unroll
    for (int ks = 0; ks < NKS; ++ks) qf[m][ks] = *(const bf16x8*)(Q + m * qmap + (size_t)(w * 32 + r) * DQK + ks * 16 + 8 * h);
#pragma unroll
  for (int m = 0; m < NMAP; ++m)
#pragma unroll
    for (int ks = 0; ks < NKS; ++ks) asm volatile("" :: "v"(qf[m][ks]));
  f32x16 O[NMAP][2];
  float mrun[NMAP], lrun[NMAP];
#pragma unroll
  for (int m = 0; m < NMAP; ++m) { mrun[m] = -1e30f; lrun[m] = 0.f;
#pragma unroll
    for (int dt = 0; dt < 2; ++dt)
#pragma unroll
      for (int i = 0; i < 16; ++i) O[m][dt][i] = 0.f; }
  u32x4 rk[NKLD], rv[2];
  const int vdv = tid >> 3, vch = tid & 7;
#define ATT_GLOAD(key0) do { \
    _Pragma("unroll") for (int i = 0; i < NKLD; ++i) { const int idx = tid + 256 * i; int go; \
      if (D32) { go = ((idx >> 2) & 63) * 32 + (idx & 3) * 8; } else { const int row = idx / 12; go = row * 96 + (idx - row * 12) * 8; } \
      rk[i] = *(const u32x4*)(Kg + (DIFF ? (size_t)i * kmap : 0) + (size_t)(key0) * DQK + go); } \
    _Pragma("unroll") for (int i = 0; i < 2; ++i) rv[i] = *(const u32x4*)(VT + (size_t)(vdv + 32 * i) * S_all + (key0) + vch * 8); } while (0)
#define ATT_SWRITE(st) do { char* base_ = smem + (st) * STAGE; \
    _Pragma("unroll") for (int i = 0; i < NKLD; ++i) { const int idx = tid + 256 * i; int so; \
      if (D32) { so = i * 64 * KROWB + ((idx >> 2) & 63) * KROWB + (idx & 3) * 16; } else { const int row = idx / 12; so = row * KROWB + (idx - row * 12) * 16; } \
      *(u32x4*)(base_ + so) = rk[i]; } \
    _Pragma("unroll") for (int i = 0; i < 2; ++i) { char* d_ = base_ + KREG + (vdv + 32 * i) * 136 + vch * 16; \
      u32x2 lo_ = {rv[i][0], rv[i][1]}, hi_ = {rv[i][2], rv[i][3]}; *(u32x2*)d_ = lo_; *(u32x2*)(d_ + 8) = hi_; } } while (0)
  ATT_GLOAD(0); ATT_SWRITE(0); __syncthreads();
  const int nt = nkeys >> 6;
  for (int t = 0; t < nt; ++t) {
    const char* cur = smem + (t & 1) * STAGE;
    if (t + 1 < nt) ATT_GLOAD((t + 1) * 64);
#pragma unroll
    for (int m = 0; m < NMAP; ++m) {
      f32x16 S[2];
#pragma unroll
      for (int kt = 0; kt < 2; ++kt)
#pragma unroll
        for (int i = 0; i < 16; ++i) S[kt][i] = 0.f;
      {
        bf16x8 kf[NKS][2];
#pragma unroll
        for (int kt = 0; kt < 2; ++kt) kf[0][kt] = *(const bf16x8*)(cur + m * 64 * KROWB + (kt * 32 + r) * KROWB + (8 * h) * 2);
#pragma unroll
        for (int ks = 0; ks < NKS; ++ks) {
          if (ks + 1 < NKS) {
#pragma unroll
            for (int kt = 0; kt < 2; ++kt) kf[ks + 1][kt] = *(const bf16x8*)(cur + m * 64 * KROWB + (kt * 32 + r) * KROWB + ((ks + 1) * 16 + 8 * h) * 2);
          }
          __builtin_amdgcn_sched_barrier(0);
#pragma unroll
          for (int kt = 0; kt < 2; ++kt) S[kt] = MFMA(kf[ks][kt], qf[m][ks], S[kt]);
          __builtin_amdgcn_sched_barrier(0);
        }
      }
      float mx = S[0][0];
#pragma unroll
      for (int kt = 0; kt < 2; ++kt)
#pragma unroll
        for (int i = 0; i < 16; ++i) mx = fmaxf(mx, S[kt][i]);
      mx = xor32_max(mx);
      const float mnew = fmaxf(mrun[m], mx);
      const float alpha = __builtin_amdgcn_exp2f(mrun[m] - mnew);
      mrun[m] = mnew;
      f32x2 ls2 = {0.f, 0.f};
      const f32x2 mneg = {-mnew, -mnew};
      bf16x8 pf[2][2];
#pragma unroll
      for (int kt = 0; kt < 2; ++kt) {
        unsigned pk[8];
#pragma unroll
        for (int i = 0; i < 8; ++i) {
          f32x2 v = {S[kt][2 * i], S[kt][2 * i + 1]};
          v = v + mneg;
          v.x = __builtin_amdgcn_exp2f(v.x); v.y = __builtin_amdgcn_exp2f(v.y);
          ls2 = ls2 + v;
          pk[i] = pack2(v.x, v.y);
        }
#pragma unroll
        for (int s2 = 0; s2 < 2; ++s2) {
          u32x4 pq = {pk[4 * s2], pk[4 * s2 + 1], pk[4 * s2 + 2], pk[4 * s2 + 3]};
          pf[kt][s2] = __builtin_bit_cast(bf16x8, pq);
        }
      }
      const float ls = ls2.x + ls2.y;
      lrun[m] = lrun[m] * alpha + ls;
#pragma unroll
      for (int dt = 0; dt < 2; ++dt)
#pragma unroll
        for (int i = 0; i < 16; ++i) O[m][dt][i] *= alpha;
#pragma unroll
      for (int kt = 0; kt < 2; ++kt)
#pragma unroll
        for (int s2 = 0; s2 < 2; ++s2) {
          bf16x8 vf[2];
#pragma unroll
          for (int dt = 0; dt < 2; ++dt) {
            const char* a = cur + KREG + (dt * 32 + r) * 136 + (kt * 32 + 16 * s2 + 4 * h) * 2;
            const s16x4 lo = *(const s16x4*)a, hi = *(const s16x4*)(a + 16);
            vf[dt] = __builtin_shufflevector(lo, hi, 0, 1, 2, 3, 4, 5, 6, 7);
          }
#pragma unroll
          for (int dt = 0; dt < 2; ++dt) O[m][dt] = MFMA(vf[dt], pf[kt][s2], O[m][dt]);
        }
      if (NMAP == 2) __builtin_amdgcn_sched_barrier(0);
    }
    if (t + 1 < nt) ATT_SWRITE((t + 1) & 1);
    __syncthreads();
  }
#undef ATT_GLOAD
#undef ATT_SWRITE
  float linv[NMAP];
#pragma unroll
  for (int m = 0; m < NMAP; ++m) { const float lt = lrun[m] + __shfl_xor(lrun[m], 32); linv[m] = 1.f / lt; }
  bf16_t* yo = Yout + (size_t)(w * 32 + r) * 1024 + 4 * h;
  if (MODE == 2) {
    float* mine = ows_pair + ((size_t)mapidx * 128 + w * 32 + r) * 64 + 4 * h;
#pragma unroll
    for (int dt = 0; dt < 2; ++dt)
#pragma unroll
      for (int g = 0; g < 4; ++g) {
        f32x4 o = {O[0][dt][4 * g] * linv[0], O[0][dt][4 * g + 1] * linv[0], O[0][dt][4 * g + 2] * linv[0], O[0][dt][4 * g + 3] * linv[0]};
#pragma unroll
        for (int j = 0; j < 4; ++j) O[0][dt][4 * g + j] = o[j];
        *(f32x4*)(mine + dt * 32 + 8 * g) = o;
      }
    asm volatile("s_waitcnt vmcnt(0)" ::: "memory");
    __syncthreads();
    if (tid == 0) {
      __builtin_amdgcn_fence(__ATOMIC_RELEASE, "agent");
      asm volatile("s_waitcnt vmcnt(0)" ::: "memory");
      const unsigned old = __hip_atomic_fetch_add(flag, 1u, __ATOMIC_RELAXED, __HIP_MEMORY_SCOPE_AGENT);
      if (old == 1u) { __builtin_amdgcn_fence(__ATOMIC_ACQUIRE, "agent"); asm volatile("s_waitcnt vmcnt(0)" ::: "memory"); }
      *s_flag = (int)old;
    }
    __syncthreads();
    if (*s_flag == 1) {
      const float* oth = ows_pair + ((size_t)(1 - mapidx) * 128 + w * 32 + r) * 64 + 4 * h;
      const float c_mine = mapidx == 0 ? 1.f : -lam, c_oth = mapidx == 0 ? -lam : 1.f;
      float ssq = 0.f;
#pragma unroll
      for (int dt = 0; dt < 2; ++dt)
#pragma unroll
        for (int g = 0; g < 4; ++g) {
          const f32x4 po = *(const f32x4*)(oth + dt * 32 + 8 * g);
#pragma unroll
          for (int j = 0; j < 4; ++j) { const float o = c_mine * O[0][dt][4 * g + j] + c_oth * po[j]; O[0][dt][4 * g + j] = o; ssq += o * o; }
        }
      ssq = xor32_sum(ssq);
      const float rn = rsqrtf(ssq * (1.f / 64.f) + 1e-6f) * oscale;
#pragma unroll
      for (int dt = 0; dt < 2; ++dt) {
#pragma unroll
        for (int g = 0; g < 4; ++g) {
          const f32x4 nw = *(const f32x4*)(normw + dt * 32 + 8 * g + 4 * h);
#pragma unroll
          for (int j = 0; j < 4; ++j) O[0][dt][4 * g + j] *= rn * nw[j];
        }
        ST_TILE32(yo - 4 * h + dt * 32, h, O[0][dt], 1.f);
      }
    }
  } else if (DIFF) {
    float ssq = 0.f;
#pragma unroll
    for (int dt = 0; dt < 2; ++dt)
#pragma unroll
      for (int i = 0; i < 16; ++i) { const float o = O[0][dt][i] * linv[0] - lam * (O[NMAP - 1][dt][i] * linv[NMAP - 1]); O[0][dt][i] = o; ssq += o * o; }
    ssq = xor32_sum(ssq);
    const float rn = rsqrtf(ssq * (1.f / 64.f) + 1e-6f) * oscale;
#pragma unroll
    for (int dt = 0; dt < 2; ++dt) {
#pragma unroll
      for (int g = 0; g < 4; ++g) {
        const f32x4 nw = *(const f32x4*)(normw + dt * 32 + 8 * g + 4 * h);
#pragma unroll
        for (int j = 0; j < 4; ++j) O[0][dt][4 * g + j] *= rn * nw[j];
      }
      ST_TILE32(yo - 4 * h + dt * 32, h, O[0][dt], 1.f);
    }
  } else {
#pragma unroll
    for (int dt = 0; dt < 2; ++dt) ST_TILE32(yo - 4 * h + dt * 32, h, O[0][dt], linv[0]);
  }
}


#define XB_TMO      128
#define XB_XCNT(j)  (256  + 64 * (j))
#define XB_XSUB(j)  (1280 + 64 * (j))
#define XB_XGEN(j)  (2304 + 64 * (j))
#define XB_TOP      3328
#define XB_TOPGEN   3392
#define XCD_BAR_WORDS 3456
#define XB_SPIN_CAP (1u << 18)
#define LAS __attribute__((address_space(3)))
DI unsigned xb_ld(unsigned* p)              { return __hip_atomic_load(p, __ATOMIC_RELAXED, __HIP_MEMORY_SCOPE_AGENT); }
DI unsigned xb_add(unsigned* p, unsigned v) { return __hip_atomic_fetch_add(p, v, __ATOMIC_RELAXED, __HIP_MEMORY_SCOPE_AGENT); }
DI unsigned xb_xcc_id() { return (unsigned)__builtin_amdgcn_s_getreg((3 << 11) | 20) & 0xFu; }
#define XB_SPIN(cond, bar) do { unsigned _sp = 0; while (cond) { __builtin_amdgcn_s_sleep(1); \
    if ((++_sp & 255u) == 0u) { if (xb_ld(&(bar)[XB_TMO])) break; if (_sp > XB_SPIN_CAP) { atomicAdd(&(bar)[XB_TMO], 1u); break; } } } } while (0)
struct XcdBarrier { unsigned* bar; unsigned x; volatile LAS unsigned* st; };
DI XcdBarrier xcd_barrier_post(unsigned* bar, volatile LAS unsigned* st) {
  XcdBarrier b; b.bar = bar; b.x = xb_xcc_id(); b.st = st;
  if (threadIdx.x == 0) (void)xb_add(&bar[XB_XCNT(b.x)], 1u);
  return b;
}
DI void xcd_barrier_complete(unsigned* bar, unsigned x, unsigned& nloc, unsigned& nx) {
  const unsigned G = gridDim.x * gridDim.y * gridDim.z;
  unsigned sum, cnt, mine, sp = 0u;
  for (;;) {
    sum = 0u; cnt = 0u; mine = 0u;
#pragma unroll
    for (unsigned j = 0; j < 16; ++j) { const unsigned c = xb_ld(&bar[XB_XCNT(j)]); sum += c; cnt += (c > 0u) ? 1u : 0u; mine = (j == x) ? c : mine; }
    if (sum == G) break;
    __builtin_amdgcn_s_sleep(1);
    if ((++sp & 255u) == 0u) { if (xb_ld(&bar[XB_TMO])) break; if (sp > XB_SPIN_CAP) { atomicAdd(&bar[XB_TMO], 1u); break; } }
  }
  nloc = mine > 0u ? mine : 1u; nx = cnt > 0u ? cnt : 1u;
}
DI void xcd_barrier(const XcdBarrier& b) {
  asm volatile("s_waitcnt vmcnt(0)" ::: "memory");
  __syncthreads();
  if (threadIdx.x == 0) {
    unsigned* bar = b.bar;
    __builtin_amdgcn_s_waitcnt(0);
    unsigned nloc = b.st[0], nx = b.st[1];
    if (nloc == 0u) { xcd_barrier_complete(bar, b.x, nloc, nx); b.st[0] = nloc; b.st[1] = nx; }
    const unsigned old = xb_add(&bar[XB_XSUB(b.x)], 1u);
    const unsigned gen = old / nloc;
    if (old + 1u == (gen + 1u) * nloc) {
      __builtin_amdgcn_fence(__ATOMIC_RELEASE, "agent");
      asm volatile("s_waitcnt vmcnt(0)" ::: "memory");
      const unsigned og = xb_add(&bar[XB_TOP], 1u);
      const unsigned tg = og / nx;
      if (og + 1u == (tg + 1u) * nx) xb_add(&bar[XB_TOPGEN], 1u);
      else XB_SPIN(xb_ld(&bar[XB_TOPGEN]) == tg, bar);
      __builtin_amdgcn_fence(__ATOMIC_ACQUIRE, "agent");
      xb_add(&bar[XB_XGEN(b.x)], 1u);
      asm volatile("s_waitcnt vmcnt(0)" ::: "memory");
    } else {
      XB_SPIN(xb_ld(&bar[XB_XGEN(b.x)]) == gen, bar);
      __builtin_amdgcn_fence(__ATOMIC_ACQUIRE, "agent");
      asm volatile("s_waitcnt vmcnt(0)" ::: "memory");
    }
  }
  __syncthreads();
}

DI void transpose_tile(const float* __restrict__ src, int ldn, int nvalid, bf16_t* __restrict__ dst, int K, const float* __restrict__ rowscale, int mode, int kt, int nt, float* tile) {
  const int tid = my_tid();
  {
    const int c4 = tid & 63, r0 = tid >> 6;
    const int n = nt * 256 + c4 * 4;
    f32x4 v[16];
#pragma unroll
    for (int i = 0; i < 16; ++i) {
      const int k = kt * 64 + r0 + 4 * i;
      v[i] = (f32x4){0.f, 0.f, 0.f, 0.f};
      if (n < nvalid) v[i] = __builtin_nontemporal_load((const f32x4*)(src + (size_t)k * ldn + n));
    }
#pragma unroll
    for (int i = 0; i < 16; ++i) {
      const int kl = r0 + 4 * i;
      f32x4 x = v[i];
      if (rowscale) { const float sc = rowscale[kt * 64 + kl]; x = x * sc; }
      float* t = tile + kl * 257 + c4 * 4;
      t[0] = x[0]; t[1] = x[1]; t[2] = x[2]; t[3] = x[3];
    }
  }
  __syncthreads();
  {
    const int q = tid & 7, nr = tid >> 3;
#pragma unroll
    for (int i = 0; i < 8; ++i) {
      const int nl = nr + 32 * i, n = nt * 256 + nl;
      int drow = n;
      if (mode == 1) drow = (n >> 5) * 64 + (n & 31);
      else if (mode == 2) drow = (n >> 5) * 64 + 32 + (n & 31);
      float v[8];
#pragma unroll
      for (int j = 0; j < 8; ++j) v[j] = tile[(q * 8 + j) * 257 + nl];
      u32x4 a = {pack2(v[0], v[1]), pack2(v[2], v[3]), pack2(v[4], v[5]), pack2(v[6], v[7])};
      *(u32x4*)(dst + (size_t)drow * K + kt * 64 + q * 8) = a;
    }
  }
  __syncthreads();
}

DI void adaln_task(const Params& p, int l, int kc, float* PART, float* sm, unsigned* done) {
  const int tid = my_tid();
  if (tid < 48) {
    const int v = tid >> 4, k = kc * 16 + (tid & 15);
    const float x = v == 0 ? p.c_ctx[k] : p.c[(v - 1) * 1024 + k];
    sm[tid] = x / (1.f + __expf(-x));
  }
  __syncthreads();
  f32x4 a0[6], a1[6], a2[6];
#pragma unroll
  for (int i = 0; i < 6; ++i) { a0[i] = (f32x4){0.f, 0.f, 0.f, 0.f}; a1[i] = a0[i]; a2[i] = a0[i]; }
  const float* wp = p.w_ada + (size_t)l * 1024 * 6144 + (size_t)(kc * 16) * 6144 + tid * 4;
#pragma unroll 4
  for (int kk = 0; kk < 16; ++kk) {
    f32x4 w[6];
#pragma unroll
    for (int i = 0; i < 6; ++i) w[i] = __builtin_nontemporal_load((const f32x4*)(wp + (size_t)kk * 6144 + i * 1024));
    const float s0 = sm[kk], s1 = sm[16 + kk], s2 = sm[32 + kk];
#pragma unroll
    for (int i = 0; i < 6; ++i) { a0[i] += w[i] * s0; a1[i] += w[i] * s1; a2[i] += w[i] * s2; }
  }
  float* m0 = PART + (((size_t)l * 64 + kc) * 3) * 6144 + tid * 4;
#pragma unroll
  for (int i = 0; i < 6; ++i) {
    *(f32x4*)(m0 + i * 1024) = a0[i];
    *(f32x4*)(m0 + 6144 + i * 1024) = a1[i];
    *(f32x4*)(m0 + 2 * 6144 + i * 1024) = a2[i];
  }
  asm volatile("s_waitcnt vmcnt(0)" ::: "memory");
  __syncthreads();
  if (tid == 0) {
    __builtin_amdgcn_fence(__ATOMIC_RELEASE, "agent");
    asm volatile("s_waitcnt vmcnt(0)" ::: "memory");
    __hip_atomic_fetch_add(done + l, 1u, __ATOMIC_RELAXED, __HIP_MEMORY_SCOPE_AGENT);
  }
}

DI void adaln_reduce(const Params& p, int chunk, const float* PART, float* MOD, unsigned* done, int rep) {
  const int tid = my_tid();
  const int l = chunk / 72, rem = chunk - l * 72, v = rem / 24, col = (rem - v * 24) * 256 + tid;
  if (tid == 0) {
    unsigned sp = 0;
    while (__hip_atomic_load(done + l, __ATOMIC_RELAXED, __HIP_MEMORY_SCOPE_AGENT) < 64u * (unsigned)(rep + 1)) { __builtin_amdgcn_s_sleep(2); if (++sp > (1u << 22)) break; }
    __builtin_amdgcn_fence(__ATOMIC_ACQUIRE, "agent");
    asm volatile("s_waitcnt vmcnt(0)" ::: "memory");
  }
  __syncthreads();
  const float* pp = PART + ((size_t)l * 64 * 3 + v) * 6144 + col;
  float s0 = 0.f, s1 = 0.f, s2 = 0.f, s3 = 0.f;
#pragma unroll 4
  for (int kc = 0; kc < 64; kc += 4) {
    s0 += __builtin_nontemporal_load(pp + (size_t)(kc + 0) * 3 * 6144); s1 += __builtin_nontemporal_load(pp + (size_t)(kc + 1) * 3 * 6144); s2 += __builtin_nontemporal_load(pp + (size_t)(kc + 2) * 3 * 6144); s3 += __builtin_nontemporal_load(pp + (size_t)(kc + 3) * 3 * 6144);
  }
  MOD[((size_t)l * 3 + v) * 6144 + col] = (s0 + s1) + (s2 + s3) + p.b_ada[l * 6144 + col];
}

__global__ void __launch_bounds__(256, 2) mega(Params p) {
  __shared__ __attribute__((aligned(16))) char smem[SMEM_BYTES];
  __shared__ int s_unit;
  __shared__ int s_flag;
  cg::grid_group grid = cg::this_grid();
  if (p.ws == nullptr) grid.sync();
  __shared__ uint4 xb_words;
  if (threadIdx.x == 0) xb_words = make_uint4(0u, 0u, 0u, 0u);
  __syncthreads();
  const XcdBarrier xbar = xcd_barrier_post((unsigned*)(p.ws + O_BAR), (volatile LAS unsigned*)&xb_words);
#define GSYNC() xcd_barrier(xbar)
  int tid = threadIdx.x;
  char* ws = p.ws;
  bf16_t* WIN = (bf16_t*)(ws + O_WIN); bf16_t* WUQ = (bf16_t*)(ws + O_WUQ); bf16_t* WUKVN = (bf16_t*)(ws + O_WUKVN); bf16_t* WUKVC = (bf16_t*)(ws + O_WUKVC);
  bf16_t* WOUT = (bf16_t*)(ws + O_WOUT); bf16_t* W13 = (bf16_t*)(ws + O_W13); bf16_t* W2 = (bf16_t*)(ws + O_W2);
  bf16_t* H = (bf16_t*)(ws + O_H); bf16_t* DKP = (bf16_t*)(ws + O_DKP); bf16_t* DKS = (bf16_t*)(ws + O_DKS); bf16_t* DVTP = (bf16_t*)(ws + O_DVTP);
  bf16_t* DVTS = (bf16_t*)(ws + O_DVTS); bf16_t* KMP = (bf16_t*)(ws + O_KMP); bf16_t* KMS = (bf16_t*)(ws + O_KMS); bf16_t* VMTP = (bf16_t*)(ws + O_VMTP);
  bf16_t* VMTS = (bf16_t*)(ws + O_VMTS); bf16_t* CKVC = (bf16_t*)(ws + O_CKVC); float* MOD = (float*)(ws + O_MOD); float* CKVF = (float*)(ws + O_CKVF);
  float* XZ = (float*)(ws + O_XZ); int* CTR = (int*)(ws + O_CTR);
  bf16_t* AX = (bf16_t*)(ws + O_AX); bf16_t* DQ = (bf16_t*)(ws + O_DQ); bf16_t* CQ = (bf16_t*)(ws + O_CQ); bf16_t* CKVB = (bf16_t*)(ws + O_CKVB);
  bf16_t* QM = (bf16_t*)(ws + O_QM); bf16_t* Y = (bf16_t*)(ws + O_Y); bf16_t* ACT = (bf16_t*)(ws + O_ACT);
  const int G = gridDim.x, bid = blockIdx.x;

  for (int rep = 0; rep < REP_P0; ++rep) {
  for (int t = bid; t < 128 + 2 * 786; t += G) {
    if (t < 128) { adaln_task(p, t >> 6, t & 63, (float*)(ws + O_PART), (float*)smem, (unsigned*)(CTR + 4)); continue; }
    int u = t - 128; const int l = u / 786; u -= l * 786;
    float* tile = (float*)smem;
    if (u < 144) { transpose_tile(p.w_in + (size_t)l * 1024 * INC, INC, INC, WIN + (size_t)l * INP * 1024, 1024, nullptr, 0, u / 9, u % 9, tile); continue; }
    u -= 144;
    if (u < 18) { transpose_tile(p.w_uq + (size_t)l * 384 * 768, 768, 768, WUQ + (size_t)l * 768 * 384, 384, p.q_norm_w + l * 384, 0, u / 3, u % 3, tile); continue; }
    u -= 18;
    if (u < 16) { transpose_tile(p.w_ukv + (size_t)l * 256 * 1024, 1024, 1024, WUKVN + (size_t)l * 1024 * 256, 256, p.kv_norm_w + l * 256, 0, u / 4, u % 4, tile); continue; }
    u -= 16;
    if (u < 16) { transpose_tile(p.w_ukv + (size_t)l * 256 * 1024, 1024, 1024, WUKVC + (size_t)l * 1024 * 256, 256, nullptr, 0, u / 4, u % 4, tile); continue; }
    u -= 16;
    if (u < 64) { transpose_tile(p.w_out + (size_t)l * 1024 * 1024, 1024, 1024, WOUT + (size_t)l * 1024 * 1024, 1024, nullptr, 0, u / 4, u % 4, tile); continue; }
    u -= 64;
    if (u < 176) { transpose_tile(p.w_ff1 + (size_t)l * 1024 * DFF, DFF, DFF, W13 + (size_t)l * 5632 * 1024, 1024, nullptr, 1, u / 11, u % 11, tile); continue; }
    u -= 176;
    if (u < 176) { transpose_tile(p.w_ff3 + (size_t)l * 1024 * DFF, DFF, DFF, W13 + (size_t)l * 5632 * 1024, 1024, nullptr, 2, u / 11, u % 11, tile); continue; }
    u -= 176;
    transpose_tile(p.w_ff2 + (size_t)l * DFF * 1024, 1024, 1024, W2 + (size_t)l * 1024 * DFF, DFF, nullptr, 0, u / 4, u % 4, tile);
  }
  {
    const int gt = bid * 256 + tid, gn = G * 256;
    for (int i8 = gt; i8 < 2 * 2 * 4 * 2 * 512 * 32 / 8; i8 += gn) {
      const int i = i8 * 8, d = i & 31, pp = (i >> 5) & 511, m = (i >> 14) & 1, hd = (i >> 15) & 3, l = (i >> 17) & 1, b = i >> 18;
      const f32x4 x0 = __builtin_nontemporal_load((const f32x4*)(p.cache_k + i)), x1 = __builtin_nontemporal_load((const f32x4*)(p.cache_k + i + 4));
      u32x4 o = {pack2(x0[0], x0[1]), pack2(x0[2], x0[3]), pack2(x1[0], x1[1]), pack2(x1[2], x1[3])};
      *(u32x4*)(DKS + (size_t)l * N_DKS + ((((size_t)b * 4 + hd) * 2 + m) * 2560 + 2048 + pp) * 32 + d) = o;
    }
    for (int i8 = gt; i8 < 2 * 2 * 4 * 64 * 512 / 8; i8 += gn) {
      const int p8 = (i8 & 63) * 8, dv = (i8 >> 6) & 63, hd = (i8 >> 12) & 3, l = (i8 >> 14) & 1, b = i8 >> 15;
      const float* sp = p.cache_v + ((((size_t)b * 2 + l) * 4 + hd) * 512 + p8) * 64 + dv;
      float x[8];
#pragma unroll
      for (int j = 0; j < 8; ++j) x[j] = __builtin_nontemporal_load(sp + j * 64);
      u32x4 o = {pack2(x[0], x[1]), pack2(x[2], x[3]), pack2(x[4], x[5]), pack2(x[6], x[7])};
      *(u32x4*)(DVTS + (size_t)l * N_DVTS + (((size_t)b * 4 + hd) * 64 + dv) * 2560 + 2048 + p8) = o;
    }
    for (int i8 = gt; i8 < 2 * 2 * 512 * 256 / 8; i8 += gn) {
      const int i = i8 * 8, cc = i & 255, pp = (i >> 8) & 511, l = (i >> 17) & 1, b = i >> 18;
      const f32x4 x0 = __builtin_nontemporal_load((const f32x4*)(p.cache_ckv + i)), x1 = __builtin_nontemporal_load((const f32x4*)(p.cache_ckv + i + 4));
      u32x4 o = {pack2(x0[0], x0[1]), pack2(x0[2], x0[3]), pack2(x1[0], x1[1]), pack2(x1[2], x1[3])};
      *(u32x4*)(CKVC + (((size_t)l * 2 + b) * 512 + pp) * 256 + cc) = o;
    }
    for (int i8 = gt; i8 < 2 * 2 * 512 * 32 / 8; i8 += gn) {
      const int j = i8 * 8, d = j & 31, pp = (j >> 5) & 511, l = (j >> 14) & 1, b = j >> 15;
      const f32x4 x0 = __builtin_nontemporal_load((const f32x4*)(p.cache_kpe + j)), x1 = __builtin_nontemporal_load((const f32x4*)(p.cache_kpe + j + 4));
      u32x4 o = {pack2(x0[0], x0[1]), pack2(x0[2], x0[3]), pack2(x1[0], x1[1]), pack2(x1[2], x1[3])};
      for (int hh = 0; hh < 8; ++hh) *(u32x4*)(KMS + (size_t)l * N_KMS + (((size_t)b * 8 + hh) * 2560 + 2048 + pp) * 96 + 64 + d) = o;
    }
  }
  for (int c = (G >= 144 ? bid - (G - 144) : bid); c < 144; c += G) if (c >= 0) adaln_reduce(p, c, (const float*)(ws + O_PART), MOD, (unsigned*)(CTR + 4), rep);
  GSYNC();
  }
  for (int rep = 0; rep < REP_SYNC; ++rep) GSYNC();

  ln_mod_pass<false>(p.x_prompt, p.x_sample, nullptr, H, nullptr, nullptr, MOD);
  GSYNC();

  for (int l = 0; l < 2; ++l) {
    const float* MODl = MOD + (size_t)l * 3 * 6144;
    float* SSQl = (float*)(ws + O_SSQ) + (size_t)l * 2 * 8192;
    bf16_t* DKSl = DKS + (size_t)l * N_DKS; bf16_t* DVTSl = DVTS + (size_t)l * N_DVTS; bf16_t* KMSl = KMS + (size_t)l * N_KMS; bf16_t* VMTSl = VMTS + (size_t)l * N_VMTS;
    for (int rep = 0; rep < REP_P1; ++rep) {
      EpiIn e{l, AX, DQ, DKP, DKSl, DVTP, DVTSl, CQ, CKVB, KMP, KMSl, CKVF, p.out, SSQl};
      const bf16_t* Bt = WIN + (size_t)l * INP * 1024;
      for (int j = bid >> 3; j < 8 * 18; j += G >> 3) gemm_tile(H, 1024, Bt, 1024, 1024, ((bid & 7) * 8 + (j & 7)) * 128, (j >> 3) * 128, smem, e);
      if (l == 0 && rep == 0) {
        const int per = G >> 3, xq = bid >> 3, nt_x = 8 * 18, first = nt_x % per;
        const int nlight = per - first;
        for (int t = (xq - first) * 8 + (bid & 7); xq >= first && t < 128; t += nlight * 8) {
          const int mt = t >> 3, ntile = t & 7, lc = mt >> 3;
          EpiUkv e2{1, nullptr, nullptr, KMS, VMTS, nullptr};
          if (__builtin_amdgcn_readfirstlane(tid >> 7)) gemm_tile<1>(CKVC, 256, WUKVC + (size_t)lc * 1024 * 256, 256, 256, mt * 128, ntile * 128, smem, e2);
          else gemm_tile<0>(CKVC, 256, WUKVC + (size_t)lc * 1024 * 256, 256, 256, mt * 128, ntile * 128, smem, e2);
        }
      }
      GSYNC();
    }
#ifdef PROBE_P1NULL
    {
      EpiInT<PROBE_P1NULL> e{l, AX, DQ, DKP, DKSl, DVTP, DVTSl, CQ, CKVB, KMP, KMSl, CKVF, p.out, SSQl};
      const bf16_t* Bt = WIN + (size_t)l * INP * 1024;
      for (int t = bid; t < 64 * 18; t += G) gemm_tile(H, 1024, Bt, 1024, 1024, (t / 18) * 128, (t % 18) * 128, smem, e);
      GSYNC();
    }
#endif
    for (int rep = 0; rep < REP_P2; ++rep) {
    for (int j = bid >> 3; j < 8 * 14; j += G >> 3) {
      const int mt = (bid & 7) * 8 + (j & 7), nn = j >> 3;
      if (nn < 6) {
        EpiUq e{QM, SSQl};
        gemm_tile(CQ, 384, WUQ + (size_t)l * 768 * 384, 384, 384, mt * 128, nn * 128, smem, e);
      } else {
        const int ntile = nn - 6;
        if (ntile == 0 && mt < 32) {
          const float* kw = p.kv_norm_w + l * 256;
          for (int i = tid; i < 128 * 64; i += 256) {
            const int row = i >> 6, c4 = (i & 63) * 4, T = mt * 128 + row, b = T >> 8, s = T & 255;
            const float rsv = rsqrtf(SSQl[8192 + T] * (1.f / 256.f) + 1e-6f);
            const f32x4 v = *(const f32x4*)(CKVF + (size_t)T * 256 + c4), wv = *(const f32x4*)(kw + c4);
            *(f32x4*)(p.out + OUT_CKV + (((size_t)b * 2 + l) * 256 + s) * 256 + c4) = v * rsv * wv;
          }
        }
        EpiUkv e{0, KMP, VMTP, KMSl, VMTSl, SSQl + 8192};
        if (__builtin_amdgcn_readfirstlane(tid >> 7)) gemm_tile<1>(CKVB, 256, WUKVN + (size_t)l * 1024 * 256, 256, 256, mt * 128, ntile * 128, smem, e);
        else gemm_tile<0>(CKVB, 256, WUKVN + (size_t)l * 1024 * 256, 256, 256, mt * 128, ntile * 128, smem, e);
      }
    }
    {
      asm volatile("" : "+v"(tid));
      const float* cw = p.conv_w + l * 768;
      for (int i = bid * 256 + tid; i < NTOK * 32; i += G * 256) {
        const int T = i >> 5, c = (i & 31) * 8;
        bool smp; int b, s; tok_decode(T, smp, b, s);
        const int slen = smp ? 2048 : 256;
        const bf16_t* row = AX + (size_t)T * 768;
        float u0[8], u1[8], u2[8], bb[8];
        {
          const u32x4 x = *(const u32x4*)(row + c), cc = *(const u32x4*)(row + 512 + c), bv = *(const u32x4*)(row + 256 + c);
#pragma unroll
          for (int j = 0; j < 4; ++j) {
            u1[2 * j] = __uint_as_float(x[j] << 16) * __uint_as_float(cc[j] << 16); u1[2 * j + 1] = __uint_as_float(x[j] & 0xffff0000u) * __uint_as_float(cc[j] & 0xffff0000u);
            bb[2 * j] = __uint_as_float(bv[j] << 16); bb[2 * j + 1] = __uint_as_float(bv[j] & 0xffff0000u);
          }
        }
        if (s > 0) {
          const u32x4 x = *(const u32x4*)(row - 768 + c), cc = *(const u32x4*)(row - 768 + 512 + c);
#pragma unroll
          for (int j = 0; j < 4; ++j) { u0[2 * j] = __uint_as_float(x[j] << 16) * __uint_as_float(cc[j] << 16); u0[2 * j + 1] = __uint_as_float(x[j] & 0xffff0000u) * __uint_as_float(cc[j] & 0xffff0000u); }
        } else {
#pragma unroll
          for (int j = 0; j < 8; ++j) u0[j] = 0.f;
        }
        if (s < slen - 1) {
          const u32x4 x = *(const u32x4*)(row + 768 + c), cc = *(const u32x4*)(row + 768 + 512 + c);
#pragma unroll
          for (int j = 0; j < 4; ++j) { u2[2 * j] = __uint_as_float(x[j] << 16) * __uint_as_float(cc[j] << 16); u2[2 * j + 1] = __uint_as_float(x[j] & 0xffff0000u) * __uint_as_float(cc[j] & 0xffff0000u); }
        } else {
#pragma unroll
          for (int j = 0; j < 8; ++j) u2[j] = 0.f;
        }
        float o[8];
#pragma unroll
        for (int q = 0; q < 2; ++q) {
          const f32x4 w0 = *(const f32x4*)(cw + c + 4 * q), w1 = *(const f32x4*)(cw + 256 + c + 4 * q), w2 = *(const f32x4*)(cw + 512 + c + 4 * q);
#pragma unroll
          for (int j = 0; j < 4; ++j) o[4 * q + j] = bb[4 * q + j] * (u0[4 * q + j] * w0[j] + u1[4 * q + j] * w1[j] + u2[4 * q + j] * w2[j]);
        }
        u32x4 ov = {pack2(o[0], o[1]), pack2(o[2], o[3]), pack2(o[4], o[5]), pack2(o[6], o[7])};
        *(u32x4*)(Y + (size_t)T * 1024 + c) = ov;
      }
    }
    GSYNC();
    }
    for (int rep = 0; rep < REP_P3; ++rep) {
      const float lam_init = l == 0 ? 0.2f : 0.8f - 0.6f * 0.7408182206817179f;
      float d1 = 0.f, d2 = 0.f;
      for (int j = 0; j < 32; ++j) { d1 += p.lq1[l * 32 + j] * p.lk1[l * 32 + j]; d2 += p.lq2[l * 32 + j] * p.lk2[l * 32 + j]; }
      const float lam = expf(d1) - expf(d2) + lam_init;
      const float* nw = p.diff_norm_w + l * 64;
      for (;;) {
        __syncthreads();
        if (tid == 0) s_unit = atomicAdd(CTR + 16 + (l + 2 * rep) * 8 + (bid & 7), 1);
        __syncthreads();
        const int vq = __builtin_amdgcn_readfirstlane(s_unit);
        if (vq >= 112) break;
        int u;
        {
          const int x = bid & 7;
          if (vq < 32) u = (2 * x + (vq >> 4)) * 16 + (vq & 15);
          else if (vq < 64) { const int v1 = vq - 32; u = 256 + (x * 16 + (v1 & 15)) * 2 + (v1 >> 4); }
          else if (vq < 96) { const int v1 = vq - 64; u = 512 + (16 * x + (v1 >> 1)) * 2 + (v1 & 1); }
          else { const int v1 = vq - 96; u = 768 + (8 * x + (v1 >> 1)) * 2 + (v1 & 1); }
        }
        const bf16_t *Qp, *Kp, *VTp; bf16_t* Yp; int S_all, mode, mapidx = 0, pairid = 0;
        if (u < 256) {
          const int b = u >> 7, hh = (u >> 4) & 7, qb = u & 15; mode = 0; S_all = 2560;
          Qp = QM + (size_t)NPR * 768 + (((size_t)b * 8 + hh) * 2048 + qb * 128) * 96; Kp = KMSl + ((size_t)b * 8 + hh) * 2560 * 96; VTp = VMTSl + ((size_t)b * 8 + hh) * 64 * 2560;
          Yp = Y + (size_t)(NPR + b * 2048 + qb * 128) * 1024 + 512 + hh * 64;
        } else if (u < 512) {
          const int v2 = u - 256; pairid = v2 >> 1; mapidx = v2 & 1;
          const int b = pairid >> 6, hd = (pairid >> 4) & 3, qb = pairid & 15; mode = 2; S_all = 2560;
          Qp = DQ + (size_t)NPR * 256 + ((((size_t)b * 4 + hd) * 2 + mapidx) * 2048 + qb * 128) * 32; Kp = DKSl + (((size_t)b * 4 + hd) * 2 + mapidx) * 2560 * 32; VTp = DVTSl + ((size_t)b * 4 + hd) * 64 * 2560;
          Yp = Y + (size_t)(NPR + b * 2048 + qb * 128) * 1024 + 256 + hd * 64;
        } else if (u < 768) {
          const int v = u - 512, b = v >> 4, hh = (v >> 1) & 7, qb = v & 1; mode = 0; S_all = 256;
          Qp = QM + (((size_t)b * 8 + hh) * 256 + qb * 128) * 96; Kp = KMP + ((size_t)b * 8 + hh) * 256 * 96; VTp = VMTP + ((size_t)b * 8 + hh) * 64 * 256;
          Yp = Y + (size_t)(b * 256 + qb * 128) * 1024 + 512 + hh * 64;
        } else {
          const int v = u - 768, b = v >> 3, hd = (v >> 1) & 3, qb = v & 1; mode = 1; S_all = 256;
          Qp = DQ + ((((size_t)b * 4 + hd) * 2) * 256 + qb * 128) * 32; Kp = DKP + (((size_t)b * 4 + hd) * 2) * 256 * 32; VTp = DVTP + ((size_t)b * 4 + hd) * 64 * 256;
          Yp = Y + (size_t)(b * 256 + qb * 128) * 1024 + 256 + hd * 64;
        }
        float* owsp = (float*)(ws + O_OWS) + ((size_t)(l * 128 + pairid) * 2) * 128 * 64;
        unsigned* flg = (unsigned*)(ws + O_FLG) + l * 128 + pairid + 256 * rep;
        if (mode == 1) attn_unit<1>(Qp, (size_t)256 * 32, Kp, (size_t)256 * 32, VTp, S_all, S_all, Yp, lam, nw, 1.f - lam_init, smem, nullptr, nullptr, 0, &s_flag);
        else if (mode == 2) attn_unit<2>(Qp, 0, Kp, 0, VTp, S_all, S_all, Yp, lam, nw, 1.f - lam_init, smem, owsp, flg, mapidx, &s_flag);
        else attn_unit<0>(Qp, 0, Kp, 0, VTp, S_all, S_all, Yp, 0.f, nw, 1.f, smem, nullptr, nullptr, 0, &s_flag);
      }
      GSYNC();
    }
    {
      EpiResLN e{l == 0 ? p.x_prompt : XZ, l == 0 ? p.x_sample : XZ + (size_t)NPR * 1024, XZ, H, MODl + 2 * 1024, p.ln1_g + l * 1024, p.ln1_b + l * 1024, MODl + 3 * 1024,
                 (unsigned long long*)(ws + O_EXCH) + (size_t)(l * 2 + 0) * 64 * 8 * 128, (unsigned*)(ws + O_LNC) + (size_t)(l * 2 + 0) * 64 * 64, smem, 0, 0};
      const bf16_t* Bt = WOUT + (size_t)l * 1024 * 1024;
      for (int j = bid >> 3; j < 8 * 8; j += G >> 3) { e.mt = (bid & 7) * 8 + (j >> 3); e.nt = j & 7; gemm_tile(Y, 1024, Bt, 1024, 1024, e.mt * 128, e.nt * 128, smem, e); }
    }
    GSYNC();
#ifdef PROBE_BD
    {
      EpiFfUp e{ACT};
      const bf16_t* Bt = W13 + (size_t)l * 5632 * 1024;
      for (int j = bid >> 3; j < 8 * 44; j += G >> 3) gemm_tile_bd(H, 1024, Bt, 1024, ((bid & 7) * 8 + (j & 7)) * 128, (j >> 3) * 128, smem, e);
      GSYNC();
    }
#endif
    for (int rep = 0; rep < REP_P6; ++rep) {
      EpiFfUp e{ACT};
      const bf16_t* Bt = W13 + (size_t)l * 5632 * 1024;
      for (int j = bid >> 3; j < 8 * 44; j += G >> 3) gemm_tile(H, 1024, Bt, 1024, 1024, ((bid & 7) * 8 + (j & 7)) * 128, (j >> 3) * 128, smem, e);
      GSYNC();
    }
    {
      EpiResLN e{XZ, XZ + (size_t)NPR * 1024, l == 0 ? XZ : p.out + OUT_Y, l == 0 ? H : nullptr, MODl + 5 * 1024, p.ln2_g + l * 1024, p.ln2_b + l * 1024, MOD + (size_t)3 * 6144,
                 (unsigned long long*)(ws + O_EXCH) + (size_t)(l * 2 + 1) * 64 * 8 * 128, (unsigned*)(ws + O_LNC) + (size_t)(l * 2 + 1) * 64 * 64, smem, 0, 0};
      const bf16_t* Bt = W2 + (size_t)l * 1024 * DFF;
      for (int j = bid >> 3; j < 8 * 8; j += G >> 3) { e.mt = (bid & 7) * 8 + (j >> 3); e.nt = j & 7; gemm_tile(ACT, DFF, Bt, DFF, DFF, e.mt * 128, e.nt * 128, smem, e); }
    }
    if (l == 0) GSYNC();
  }
}

extern "C" void kernel_launch(void* const* d_in, const int* in_sizes, int n_in, void* d_out, int out_size, void* d_ws, size_t ws_size, hipStream_t stream) {
  static int grid_blocks = 0;
  if (!grid_blocks) {
    int dev = 0, cus = 0, per_cu = 0;
    hipGetDevice(&dev);
    hipDeviceGetAttribute(&cus, hipDeviceAttributeMultiprocessorCount, dev);
    hipOccupancyMaxActiveBlocksPerMultiprocessor(&per_cu, mega, 256, 0);
    if (per_cu > 2) per_cu = 2;
    if (per_cu < 1) per_cu = 1;
    grid_blocks = (cus * per_cu) & ~7;
  }
  if (ws_size < WS_NEED) { fprintf(stderr, "workspace too small: %zu < %zu\n", ws_size, (size_t)WS_NEED); return; }
  Params p{};
  const float** pp = (const float**)&p;
  for (int i = 0; i < 29; ++i) pp[i] = (const float*)d_in[i];
  p.out = (float*)d_out; p.ws = (char*)d_ws;
  hipMemsetAsync((char*)d_ws + O_CTR, 0, O_OVL - O_CTR, stream);
  void* args[] = {&p};
  hipError_t e = hipLaunchCooperativeKernel((void*)mega, dim3(grid_blocks), dim3(256), args, 0, stream);
  if (e != hipSuccess) fprintf(stderr, "cooperative launch failed: %s (grid %d)\n", hipGetErrorString(e), grid_blocks);
}
```

```cpp
#include <hip/hip_runtime.h>
#include <hip/hip_cooperative_groups.h>
#include <cstdio>
#include <cstdint>
namespace cg = cooperative_groups;

typedef unsigned short bf16_t;
typedef short bf16x8 __attribute__((ext_vector_type(8)));
typedef short s16x4 __attribute__((ext_vector_type(4)));
typedef float f32x16 __attribute__((ext_vector_type(16)));
typedef float f32x4 __attribute__((ext_vector_type(4)));
typedef float f32x2 __attribute__((ext_vector_type(2)));
typedef unsigned u32x4 __attribute__((ext_vector_type(4)));
typedef unsigned u32x2 __attribute__((ext_vector_type(2)));
typedef __bf16 bf2_t __attribute__((ext_vector_type(2)));

#ifndef REP_P0
#define REP_P0 1
#endif
#ifndef REP_P1
#define REP_P1 1
#endif
#ifndef REP_P2
#define REP_P2 1
#endif
#ifndef REP_P3
#define REP_P3 1
#endif
#ifndef REP_P6
#define REP_P6 1
#endif
#ifndef REP_SYNC
#define REP_SYNC 0
#endif
#define DI __device__ __forceinline__
#define MFMA(a, b, c) __builtin_amdgcn_mfma_f32_32x32x16_bf16((a), (b), (c), 0, 0, 0)

constexpr int NTOK = 8192, NPR = 4096, DM = 1024, INC = 2208, INP = 2304, DFF = 2816;
constexpr float LOG2E = 1.4426950408889634f;
constexpr float ALPHA = 1.4142135623730951f;
constexpr float QSC_DIFF = 0.17677669529663687f * LOG2E;
constexpr float QSC_MLA = 0.10206207261596575f * LOG2E;

constexpr size_t al(size_t x) { return (x + 255) & ~(size_t)255; }
constexpr size_t O_WIN = 0;
constexpr size_t O_WUQ = O_WIN + al(2ull * INP * 1024 * 2);
constexpr size_t O_WUKVN = O_WUQ + al(2ull * 768 * 384 * 2);
constexpr size_t O_WUKVC = O_WUKVN + al(2ull * 1024 * 256 * 2);
constexpr size_t O_WOUT = O_WUKVC + al(2ull * 1024 * 256 * 2);
constexpr size_t O_W13 = O_WOUT + al(2ull * 1024 * 1024 * 2);
constexpr size_t O_W2 = O_W13 + al(2ull * 5632 * 1024 * 2);
constexpr size_t O_H = O_W2 + al(2ull * 1024 * 2816 * 2);
constexpr size_t O_DKP = O_H + al(8192ull * 1024 * 2);
constexpr size_t N_DKS = 2ull * 4 * 2 * 2560 * 32;
constexpr size_t O_DKS = O_DKP + al(16ull * 4 * 2 * 256 * 32 * 2);
constexpr size_t O_DVTP = O_DKS + al(2 * N_DKS * 2);
constexpr size_t N_DVTS = 2ull * 4 * 64 * 2560;
constexpr size_t O_DVTS = O_DVTP + al(16ull * 4 * 64 * 256 * 2);
constexpr size_t O_KMP = O_DVTS + al(2 * N_DVTS * 2);
constexpr size_t N_KMS = 2ull * 8 * 2560 * 96;
constexpr size_t O_KMS = O_KMP + al(16ull * 8 * 256 * 96 * 2);
constexpr size_t O_VMTP = O_KMS + al(2 * N_KMS * 2);
constexpr size_t N_VMTS = 2ull * 8 * 64 * 2560;
constexpr size_t O_VMTS = O_VMTP + al(16ull * 8 * 64 * 256 * 2);
constexpr size_t O_CKVC = O_VMTS + al(2 * N_VMTS * 2);
constexpr size_t O_CKVF = O_CKVC + al(2ull * 2 * 512 * 256 * 2);
constexpr size_t O_XZ = O_CKVF + al(4096ull * 256 * 4);
constexpr size_t O_EXCH = O_XZ + al(8192ull * 1024 * 4);
constexpr size_t O_OWS = O_EXCH + al(4ull * 64 * 8 * 128 * 8);
constexpr size_t O_PART = O_OWS + al(2ull * 128 * 2 * 128 * 64 * 4);
constexpr size_t O_CTR = O_PART + al(2ull * 64 * 3 * 6144 * 4);
constexpr size_t O_BAR = O_CTR + 256;
constexpr size_t O_SSQ = O_BAR + al(3456 * 4);
constexpr size_t O_FLG = O_SSQ + al(2ull * 2 * 8192 * 4);
constexpr size_t O_MOD = O_FLG + al(4ull * 128 * 4);
constexpr size_t O_LNC = O_MOD + al(2ull * 3 * 6144 * 4);
constexpr size_t O_OVL = O_LNC + al(4ull * 64 * 64 * 4);
constexpr size_t O_AX = O_OVL;
constexpr size_t O_DQ = O_AX + al(8192ull * 768 * 2);
constexpr size_t O_CQ = O_DQ + al(8192ull * 256 * 2);
constexpr size_t O_CKVB = O_CQ + al(8192ull * 384 * 2);
constexpr size_t O_QM = O_CKVB + al(8192ull * 256 * 2);
constexpr size_t O_Y = O_QM + al(8192ull * 768 * 2);
constexpr size_t O_END1 = O_Y + al(8192ull * 1024 * 2);
constexpr size_t O_ACT = O_OVL;
constexpr size_t O_END2 = O_ACT + al(8192ull * 2816 * 2);
constexpr size_t WS_NEED = O_END1 > O_END2 ? O_END1 : O_END2;
static_assert(WS_NEED <= (256ull << 20), "workspace too large");

constexpr size_t OUT_Y = 0;
constexpr size_t OUT_SK = 8388608;
constexpr size_t OUT_SV = 10485760;
constexpr size_t OUT_CKV = 12582912;
constexpr size_t OUT_KPE = 14680064;

constexpr int SMEM_BYTES = 65536 + 4096;

struct Params {
  const float* x_prompt; const float* x_sample; const float* cache_k; const float* cache_v; const float* cache_ckv; const float* cache_kpe;
  const float* c; const float* c_ctx; const float* w_ada; const float* b_ada; const float* w_in; const float* conv_w;
  const float* lq1; const float* lk1; const float* lq2; const float* lk2; const float* diff_norm_w; const float* q_norm_w; const float* w_uq;
  const float* kv_norm_w; const float* w_ukv; const float* w_out; const float* ln1_g; const float* ln1_b; const float* w_ff1; const float* w_ff3;
  const float* w_ff2; const float* ln2_g; const float* ln2_b;
  float* out; char* ws;
};

DI int my_tid() { int t = threadIdx.x; asm volatile("" : "+v"(t)); return t; }
DI unsigned pack2(float lo, float hi) {
  f32x2 v = {lo, hi};
  bf2_t b = __builtin_convertvector(v, bf2_t);
  return __builtin_bit_cast(unsigned, b);
}
DI bf16_t f2bf(float x) { return (bf16_t)(pack2(x, 0.f) & 0xffffu); }
DI void st4bf(bf16_t* p, float a, float b, float c, float d) { u32x2 v = {pack2(a, b), pack2(c, d)}; *(u32x2*)p = v; }
DI void st_tile32_bf16(bf16_t* p0, int h, float v0, float v1, float v2, float v3, float v4, float v5, float v6, float v7,
                       float v8, float v9, float v10, float v11, float v12, float v13, float v14, float v15) {
  unsigned a0 = pack2(v0, v1), a1 = pack2(v2, v3), b0 = pack2(v4, v5), b1 = pack2(v6, v7);
  unsigned c0 = pack2(v8, v9), c1 = pack2(v10, v11), d0 = pack2(v12, v13), d1 = pack2(v14, v15);
  { auto r0 = __builtin_amdgcn_permlane32_swap(a0, b0, false, false); auto r1 = __builtin_amdgcn_permlane32_swap(a1, b1, false, false);
    u32x4 o = {r0[0], r1[0], r0[1], r1[1]}; *(u32x4*)(p0 + 8 * h) = o; }
  { auto r0 = __builtin_amdgcn_permlane32_swap(c0, d0, false, false); auto r1 = __builtin_amdgcn_permlane32_swap(c1, d1, false, false);
    u32x4 o = {r0[0], r1[0], r0[1], r1[1]}; *(u32x4*)(p0 + 16 + 8 * h) = o; }
}
#define ST_TILE32(P0, H, V, SC) st_tile32_bf16((P0), (H), (V)[0] * (SC), (V)[1] * (SC), (V)[2] * (SC), (V)[3] * (SC), (V)[4] * (SC), (V)[5] * (SC), (V)[6] * (SC), (V)[7] * (SC), \
    (V)[8] * (SC), (V)[9] * (SC), (V)[10] * (SC), (V)[11] * (SC), (V)[12] * (SC), (V)[13] * (SC), (V)[14] * (SC), (V)[15] * (SC))
DI float xor32_max(float x) { auto r = __builtin_amdgcn_permlane32_swap(__float_as_uint(x), __float_as_uint(x), false, false); return fmaxf(__uint_as_float(r[0]), __uint_as_float(r[1])); }
DI float xor32_sum(float x) { auto r = __builtin_amdgcn_permlane32_swap(__float_as_uint(x), __float_as_uint(x), false, false); return __uint_as_float(r[0]) + __uint_as_float(r[1]); }
DI float bf2f(bf16_t x) { return __uint_as_float(((unsigned)x) << 16); }

DI void rope16(f32x16& v, int s, int h) {
  const float pr = (float)(s >> 6), pc = (float)(s & 63);
#pragma unroll
  for (int i = 0; i < 4; ++i) {
    const float f = __builtin_amdgcn_exp2f(-1.6609640474436813f * (float)(4 * h + i));
    const float a1 = pr * f, a2 = pc * f;
    const float c1 = __cosf(a1), s1 = __sinf(a1), c2 = __cosf(a2), s2 = __sinf(a2);
    const float x1 = v[i], x2 = v[4 + i];
    v[i] = x1 * c1 - x2 * s1; v[4 + i] = x1 * s1 + x2 * c1;
    const float y1 = v[8 + i], y2 = v[12 + i];
    v[8 + i] = y1 * c2 - y2 * s2; v[12 + i] = y1 * s2 + y2 * c2;
  }
}

template <int SWAPMODE = 0, class Epi>
DI void gemm_tile(const bf16_t* __restrict__ A, int lda, const bf16_t* __restrict__ Bt, int ldb, int K, int m0, int n0, char* smem, const Epi& epi) {
  const int tid = my_tid(), lane = tid & 63, w = tid >> 6, wm = w & 1, wn = w >> 1, r = lane & 31, h = lane >> 5;
  constexpr bool swp = SWAPMODE == 1;
  f32x16 acc[2][2];
#pragma unroll
  for (int a = 0; a < 2; ++a)
#pragma unroll
    for (int b = 0; b < 2; ++b)
#pragma unroll
      for (int i = 0; i < 16; ++i) acc[a][b][i] = 0.f;
  const int srow = tid >> 3, sch = tid & 7;
  const bf16_t* ga = A + (size_t)(m0 + srow) * lda + sch * 8;
  const bf16_t* gb = Bt + (size_t)(n0 + srow) * ldb + sch * 8;
  const int swoff = srow * 128 + ((sch ^ ((srow >> 1) & 7)) << 4);
  u32x4 ra0[4], rb0[4], ra1[4], rb1[4];
  const int nk = K >> 6;
  const int sw = (r >> 1) & 7;
  const int arow = (wm * 64 + r) * 128, brow = 16384 + (wn * 64 + r) * 128;
#define G_LOAD(RA, RB, KT) do { _Pragma("unroll") for (int i = 0; i < 4; ++i) { RA[i] = *(const u32x4*)(ga + (size_t)(32 * i) * lda + (KT) * 64); RB[i] = *(const u32x4*)(gb + (size_t)(32 * i) * ldb + (KT) * 64); } } while (0)
#define S_WRITE(RA, RB, ST) do { _Pragma("unroll") for (int i = 0; i < 4; ++i) { *(u32x4*)(smem + (ST) * 32768 + swoff + i * 4096) = RA[i]; *(u32x4*)(smem + (ST) * 32768 + 16384 + swoff + i * 4096) = RB[i]; } } while (0)
#define G_FRAGS(ST, KK, FA, FB) do { const int co_ = (((KK) * 2 + h) ^ sw) << 4; \
    _Pragma("unroll") for (int mi = 0; mi < 2; ++mi) FA[mi] = *(const bf16x8*)(smem + (ST) * 32768 + arow + mi * 4096 + co_); \
    _Pragma("unroll") for (int ni = 0; ni < 2; ++ni) FB[ni] = *(const bf16x8*)(smem + (ST) * 32768 + brow + ni * 4096 + co_); } while (0)
#define G_MMA(FA, FB) do { if (SWAPMODE != 0 && swp) { _Pragma("unroll") for (int mi = 0; mi < 2; ++mi) _Pragma("unroll") for (int ni = 0; ni < 2; ++ni) acc[mi][ni] = MFMA(FA[mi], FB[ni], acc[mi][ni]); } \
    else { _Pragma("unroll") for (int mi = 0; mi < 2; ++mi) _Pragma("unroll") for (int ni = 0; ni < 2; ++ni) acc[mi][ni] = MFMA(FB[ni], FA[mi], acc[mi][ni]); } } while (0)
#define G_COMPUTE(ST) do { bf16x8 fa0[2], fb0[2], fa1[2], fb1[2]; \
    G_FRAGS(ST, 0, fa0, fb0); \
    G_FRAGS(ST, 1, fa1, fb1); __builtin_amdgcn_sched_barrier(0); \
    G_MMA(fa0, fb0); __builtin_amdgcn_sched_barrier(0); \
    G_FRAGS(ST, 2, fa0, fb0); __builtin_amdgcn_sched_barrier(0); \
    G_MMA(fa1, fb1); __builtin_amdgcn_sched_barrier(0); \
    G_FRAGS(ST, 3, fa1, fb1); __builtin_amdgcn_sched_barrier(0); \
    G_MMA(fa0, fb0); __builtin_amdgcn_sched_barrier(0); \
    G_MMA(fa1, fb1); } while (0)
  G_LOAD(ra0, rb0, 0);
  G_LOAD(ra1, rb1, 1);
  S_WRITE(ra0, rb0, 0);
  __syncthreads();
  for (int kt = 0; kt < nk; kt += 2) {
    G_LOAD(ra0, rb0, (kt + 2 < nk ? kt + 2 : nk - 1));
    G_COMPUTE(0);
    S_WRITE(ra1, rb1, 1);
    __syncthreads();
    G_LOAD(ra1, rb1, (kt + 3 < nk ? kt + 3 : nk - 1));
    G_COMPUTE(1);
    S_WRITE(ra0, rb0, 0);
    __syncthreads();
  }
#undef G_LOAD
#undef S_WRITE
#undef G_COMPUTE
#undef G_FRAGS
#undef G_MMA
  epi(acc, m0 + wm * 64, n0 + wn * 64, r, h);
}


template <class Epi>
DI void gemm_phase(const bf16_t* __restrict__ A, int lda, const bf16_t* __restrict__ Bt, int ldb, int K, int x8, int j0, int jend, int jstep, char* smem, const Epi& epi) {
  if (j0 >= jend) return;
  const int tid = my_tid(), lane = tid & 63, w = tid >> 6, wm = w & 1, wn = w >> 1, r = lane & 31, h = lane >> 5;
  const int srow = tid >> 3, sch = tid & 7;
  const int swoff = srow * 128 + ((sch ^ ((srow >> 1) & 7)) << 4);
  u32x4 ra0[4], rb0[4], ra1[4], rb1[4];
  const int nk = K >> 6;
  const int sw = (r >> 1) & 7;
  const int arow = (wm * 64 + r) * 128, brow = 16384 + (wn * 64 + r) * 128;
#define P_LOAD(RA, RB, PA, PB) do { _Pragma("unroll") for (int i = 0; i < 4; ++i) { RA[i] = *(const u32x4*)((PA) + (size_t)(32 * i) * lda); RB[i] = *(const u32x4*)((PB) + (size_t)(32 * i) * ldb); } } while (0)
#define S_WRITE(RA, RB, ST) do { _Pragma("unroll") for (int i = 0; i < 4; ++i) { *(u32x4*)(smem + (ST) * 32768 + swoff + i * 4096) = RA[i]; *(u32x4*)(smem + (ST) * 32768 + 16384 + swoff + i * 4096) = RB[i]; } } while (0)
#define G_FRAGS(ST, KK, FA, FB) do { const int co_ = (((KK) * 2 + h) ^ sw) << 4; \
    _Pragma("unroll") for (int mi = 0; mi < 2; ++mi) FA[mi] = *(const bf16x8*)(smem + (ST) * 32768 + arow + mi * 4096 + co_); \
    _Pragma("unroll") for (int ni = 0; ni < 2; ++ni) FB[ni] = *(const bf16x8*)(smem + (ST) * 32768 + brow + ni * 4096 + co_); } while (0)
#define G_MMA(FA, FB) do { _Pragma("unroll") for (int mi = 0; mi < 2; ++mi) _Pragma("unroll") for (int ni = 0; ni < 2; ++ni) acc[mi][ni] = MFMA(FB[ni], FA[mi], acc[mi][ni]); } while (0)
#define G_COMPUTE(ST) do { bf16x8 fa0[2], fb0[2], fa1[2], fb1[2]; \
    G_FRAGS(ST, 0, fa0, fb0); \
    G_FRAGS(ST, 1, fa1, fb1); __builtin_amdgcn_sched_barrier(0); \
    G_MMA(fa0, fb0); __builtin_amdgcn_sched_barrier(0); \
    G_FRAGS(ST, 2, fa0, fb0); __builtin_amdgcn_sched_barrier(0); \
    G_MMA(fa1, fb1); __builtin_amdgcn_sched_barrier(0); \
    G_FRAGS(ST, 3, fa1, fb1); __builtin_amdgcn_sched_barrier(0); \
    G_MMA(fa0, fb0); __builtin_amdgcn_sched_barrier(0); \
    G_MMA(fa1, fb1); } while (0)
  int j = j0;
  int m0 = (x8 + (j & 7)) * 128, n0 = (j >> 3) * 128;
  const bf16_t* ga = A + (size_t)(m0 + srow) * lda + sch * 8;
  const bf16_t* gb = Bt + (size_t)(n0 + srow) * ldb + sch * 8;
  P_LOAD(ra0, rb0, ga, gb);
  P_LOAD(ra1, rb1, ga + 64, gb + 64);
  S_WRITE(ra0, rb0, 0);
  __syncthreads();
  for (;;) {
    const int jn = j + jstep;
    const bool has_next = jn < jend;
    const int m1 = has_next ? (x8 + (jn & 7)) * 128 : m0, n1 = has_next ? (jn >> 3) * 128 : n0;
    const bf16_t* gan = A + (size_t)(m1 + srow) * lda + sch * 8;
    const bf16_t* gbn = Bt + (size_t)(n1 + srow) * ldb + sch * 8;
    f32x16 acc[2][2];
#pragma unroll
    for (int a = 0; a < 2; ++a)
#pragma unroll
      for (int b = 0; b < 2; ++b)
#pragma unroll
        for (int i = 0; i < 16; ++i) acc[a][b][i] = 0.f;
    for (int kt = 0; kt < nk; kt += 2) {
      const bool last = kt + 2 >= nk;
      const bf16_t* pa = last ? gan : ga + (kt + 2) * 64; const bf16_t* pb = last ? gbn : gb + (kt + 2) * 64;
      P_LOAD(ra0, rb0, pa, pb);
      G_COMPUTE(0);
      S_WRITE(ra1, rb1, 1);
      __syncthreads();
      P_LOAD(ra1, rb1, pa + 64, pb + 64);
      G_COMPUTE(1);
      S_WRITE(ra0, rb0, 0);
      __syncthreads();
    }
    epi(acc, m0 + wm * 64, n0 + wn * 64, r, h);
    if (!has_next) break;
    j = jn; m0 = m1; n0 = n1; ga = gan; gb = gbn;
  }
#undef P_LOAD
#undef S_WRITE
#undef G_COMPUTE
#undef G_FRAGS
#undef G_MMA
}

template <class Epi>
DI void gemm_tile_bd(const bf16_t* __restrict__ A, int lda, const bf16_t* __restrict__ Bf, int K, int m0, int n0, char* smem, const Epi& epi) {
  const int tid = my_tid(), lane = tid & 63, w = tid >> 6, wm = w & 1, wn = w >> 1, r = lane & 31, h = lane >> 5;
  f32x16 acc[2][2];
#pragma unroll
  for (int a = 0; a < 2; ++a)
#pragma unroll
    for (int b = 0; b < 2; ++b)
#pragma unroll
      for (int i = 0; i < 16; ++i) acc[a][b][i] = 0.f;
  const int srow = tid >> 3, sch = tid & 7;
  const bf16_t* ga = A + (size_t)(m0 + srow) * lda + sch * 8;
  const int swoff = srow * 128 + ((sch ^ ((srow >> 1) & 7)) << 4);
  const int k16 = K >> 4;
  const bf16_t* gb0 = Bf + ((size_t)(((n0 + wn * 64) >> 5) + 0) * k16 * 64 + lane) * 8;
  const bf16_t* gb1 = Bf + ((size_t)(((n0 + wn * 64) >> 5) + 1) * k16 * 64 + lane) * 8;
  u32x4 ra0[4], ra1[4];
  bf16x8 bq0[2][4], bq1[2][4];
  const int nk = K >> 6;
  const int sw = (r >> 1) & 7;
  const int arow = (wm * 64 + r) * 128;
#define GA_LOAD(RA, KT) do { _Pragma("unroll") for (int i = 0; i < 4; ++i) RA[i] = *(const u32x4*)(ga + (size_t)(32 * i) * lda + (KT) * 64); } while (0)
#define GB_LOAD(BQ, KT) do { _Pragma("unroll") for (int kk = 0; kk < 4; ++kk) { BQ[0][kk] = *(const bf16x8*)(gb0 + (size_t)((KT) * 4 + kk) * 512); BQ[1][kk] = *(const bf16x8*)(gb1 + (size_t)((KT) * 4 + kk) * 512); } } while (0)
#define SA_WRITE(RA, ST) do { _Pragma("unroll") for (int i = 0; i < 4; ++i) *(u32x4*)(smem + (ST) * 16384 + swoff + i * 4096) = RA[i]; } while (0)
#define GBD_COMPUTE(ST, BQ) do { _Pragma("unroll") for (int kk = 0; kk < 4; ++kk) { const int co = ((kk * 2 + h) ^ sw) << 4; bf16x8 fa[2]; \
    _Pragma("unroll") for (int mi = 0; mi < 2; ++mi) fa[mi] = *(const bf16x8*)(smem + (ST) * 16384 + arow + mi * 4096 + co); \
    _Pragma("unroll") for (int mi = 0; mi < 2; ++mi) _Pragma("unroll") for (int ni = 0; ni < 2; ++ni) acc[mi][ni] = MFMA(BQ[ni][kk], fa[mi], acc[mi][ni]); } } while (0)
  GA_LOAD(ra0, 0);
  GA_LOAD(ra1, 1);
  GB_LOAD(bq0, 0);
  SA_WRITE(ra0, 0);
  __syncthreads();
  for (int kt = 0; kt < nk; kt += 2) {
    GB_LOAD(bq1, kt + 1);
    if (kt + 2 < nk) GA_LOAD(ra0, kt + 2);
    GBD_COMPUTE(0, bq0);
    SA_WRITE(ra1, 1);
    __syncthreads();
    if (kt + 2 < nk) GB_LOAD(bq0, kt + 2);
    if (kt + 3 < nk) GA_LOAD(ra1, kt + 3);
    GBD_COMPUTE(1, bq1);
    if (kt + 2 < nk) SA_WRITE(ra0, 0);
    __syncthreads();
  }
#undef GA_LOAD
#undef GB_LOAD
#undef SA_WRITE
#undef GBD_COMPUTE
  epi(acc, m0 + wm * 64, n0 + wn * 64, r, h);
}

DI void row_rms(const bf16_t* __restrict__ A, int lda, int K, int m0, float* rs) {
  const int tid = my_tid(), row = tid >> 1, half = tid & 1;
  const bf16_t* p = A + (size_t)(m0 + row) * lda + half * (K >> 1);
  float s = 0.f;
  for (int k = 0; k < (K >> 1); k += 8) {
    u32x4 v = *(const u32x4*)(p + k);
#pragma unroll
    for (int j = 0; j < 4; ++j) { float a = __uint_as_float(v[j] << 16), b = __uint_as_float(v[j] & 0xffff0000u); s += a * a + b * b; }
  }
  s += __shfl_xor(s, 1);
  if (half == 0) rs[row] = rsqrtf(s / (float)K + 1e-6f);
}

DI void tok_decode(int T, bool& smp, int& b, int& s) {
  smp = T >= NPR;
  if (!smp) { b = T >> 8; s = T & 255; } else { const int t2 = T - NPR; b = t2 >> 11; s = t2 & 2047; }
}

template <int MASK> struct EpiInT {
  int l; bf16_t *AX, *DQ, *DKP, *DKS, *DVTP, *DVTS, *CQ, *CKVB, *KMP, *KMS; float* CKVF; float* out; float* SSQ;
  DI void operator()(f32x16 (&acc)[2][2], int tb, int nb, int r, int h) const {
#pragma unroll
    for (int mi = 0; mi < 2; ++mi) {
      const int T = tb + mi * 32 + r; bool smp; int b, s; tok_decode(T, smp, b, s);
#pragma unroll
      for (int ni = 0; ni < 2; ++ni) {
        const int nt = nb + ni * 32; f32x16 v = acc[mi][ni];
        if (nt < 768) { if (MASK & 1) {
          ST_TILE32(AX + (size_t)T * 768 + nt, h, v, 1.f);
        } } else if (nt < 1024) { if (MASK & 2) {
          const int c = nt - 768, hd = c >> 6, mp = (c >> 5) & 1;
          if (smp) rope16(v, s, h);
          const size_t base = smp ? (size_t)NPR * 256 + ((((size_t)b * 4 + hd) * 2 + mp) * 2048 + s) * 32 : ((((size_t)b * 4 + hd) * 2 + mp) * 256 + s) * 32;
          ST_TILE32(DQ + base, h, v, QSC_DIFF);
        } } else if (nt < 1280) { if (MASK & 2) {
          const int c = nt - 1024, hd = c >> 6, mp = (c >> 5) & 1;
          if (!smp) {
            float* o = out + OUT_SK + ((((((size_t)b * 2 + l) * 4 + hd) * 2 + mp) * 256 + s) * 32) + 4 * h;
            bf16_t* d = DKP + ((((size_t)b * 4 + hd) * 2 + mp) * 256 + s) * 32 + 4 * h;
#pragma unroll
            for (int g = 0; g < 4; ++g) { f32x4 t = {v[4 * g], v[4 * g + 1], v[4 * g + 2], v[4 * g + 3]}; *(f32x4*)(o + 8 * g) = t; }
            ST_TILE32(d - 4 * h, h, v, 1.f);
          } else {
            rope16(v, s, h);
            ST_TILE32(DKS + ((((size_t)b * 4 + hd) * 2 + mp) * 2560 + s) * 32, h, v, 1.f);
          }
        } } else if (nt < 1536) { if (MASK & 4) {
          const int c = nt - 1280, hd = c >> 6, dvb = c & 63;
          if (!smp) {
            float* o = out + OUT_SV + (((((size_t)b * 2 + l) * 4 + hd) * 256 + s) * 64) + dvb + 4 * h;
            bf16_t* d = DVTP + (((size_t)b * 4 + hd) * 64 + dvb + 4 * h) * 256 + s;
#pragma unroll
            for (int g = 0; g < 4; ++g) {
              f32x4 t = {v[4 * g], v[4 * g + 1], v[4 * g + 2], v[4 * g + 3]}; *(f32x4*)(o + 8 * g) = t;
#pragma unroll
              for (int j = 0; j < 4; ++j) d[(size_t)(8 * g + j) * 256] = f2bf(t[j]);
            }
          } else {
            bf16_t* d = DVTS + (((size_t)b * 4 + hd) * 64 + dvb + 4 * h) * 2560 + s;
#pragma unroll
            for (int g = 0; g < 4; ++g)
#pragma unroll
              for (int j = 0; j < 4; ++j) d[(size_t)(8 * g + j) * 2560] = f2bf(v[4 * g + j]);
          }
        } } else if (nt < 1920) { if (MASK & 1) {
          ST_TILE32(CQ + (size_t)T * 384 + (nt - 1536), h, v, 1.f);
          { float sq = 0.f;
#pragma unroll
            for (int i = 0; i < 16; ++i) sq += v[i] * v[i];
            sq = xor32_sum(sq);
            if (h == 0) atomicAdd(SSQ + T, sq); }
        } } else if (nt < 2176) { if (MASK & 8) {
          ST_TILE32(CKVB + (size_t)T * 256 + (nt - 1920), h, v, 1.f);
          { float sq = 0.f;
#pragma unroll
            for (int i = 0; i < 16; ++i) sq += v[i] * v[i];
            sq = xor32_sum(sq);
            if (h == 0) atomicAdd(SSQ + 8192 + T, sq); }
          if (!smp) {
            float* o = CKVF + (size_t)T * 256 + (nt - 1920) + 4 * h;
#pragma unroll
            for (int g = 0; g < 4; ++g) { f32x4 t = {v[4 * g], v[4 * g + 1], v[4 * g + 2], v[4 * g + 3]}; *(f32x4*)(o + 8 * g) = t; }
          }
        } } else if (nt < 2208) { if (MASK & 16) {
          if (!smp) {
            float* o = out + OUT_KPE + (((size_t)b * 2 + l) * 256 + s) * 32 + 4 * h;
#pragma unroll
            for (int g = 0; g < 4; ++g) { f32x4 t = {v[4 * g], v[4 * g + 1], v[4 * g + 2], v[4 * g + 3]}; *(f32x4*)(o + 8 * g) = t; }
            for (int hh = 0; hh < 8; ++hh) {
              ST_TILE32(KMP + (((size_t)b * 8 + hh) * 256 + s) * 96 + 64, h, v, 1.f);
            }
          } else {
            rope16(v, s, h);
            for (int hh = 0; hh < 8; ++hh) {
              ST_TILE32(KMS + (((size_t)b * 8 + hh) * 2560 + s) * 96 + 64, h, v, 1.f);
            }
          }
        } }
      }
    }
  }
};
typedef EpiInT<31> EpiIn;

struct EpiNull { float* sink;
  DI void operator()(f32x16 (&acc)[2][2], int tb, int nb, int r, int h) const {
    float s = 0.f;
#pragma unroll
    for (int a = 0; a < 2; ++a)
#pragma unroll
      for (int b = 0; b < 2; ++b)
#pragma unroll
        for (int i = 0; i < 16; ++i) s += acc[a][b][i];
    if (s == 12345.678f) sink[tb + r] = s;
  }
};
struct EpiUq {
  bf16_t* QM; const float* ssq;
  DI void operator()(f32x16 (&acc)[2][2], int tb, int nb, int r, int h) const {
#pragma unroll
    for (int mi = 0; mi < 2; ++mi) {
      const int T = tb + mi * 32 + r; bool smp; int b, s; tok_decode(T, smp, b, s);
      const float sc = rsqrtf(ssq[T] * (1.f / 384.f) + 1e-6f) * QSC_MLA;
#pragma unroll
      for (int ni = 0; ni < 2; ++ni) {
        const int nt = nb + ni * 32; f32x16 v = acc[mi][ni];
        const int hh = nt / 96, dd0 = nt - hh * 96;
        if (dd0 == 64 && smp) rope16(v, s, h);
        const size_t base = smp ? (size_t)NPR * 768 + (((size_t)b * 8 + hh) * 2048 + s) * 96 : (((size_t)b * 8 + hh) * 256 + s) * 96;
        ST_TILE32(QM + base + dd0, h, v, sc);
      }
    }
  }
};

struct EpiUkv {
  int mode; bf16_t *KMP, *VMTP, *KMS, *VMTS;   const float* ssq;
  DI void operator()(f32x16 (&acc)[2][2], int tb, int nb, int r, int h) const {
    if (__builtin_amdgcn_readfirstlane(nb & 64)) {
#pragma unroll
      for (int mi = 0; mi < 2; ++mi) {
        const int R0 = __builtin_amdgcn_readfirstlane(tb) + mi * 32;
        bf16_t* vmt; int b, s0, S_all;
        if (mode == 0) {
          bool smp; tok_decode(R0, smp, b, s0);
          if (smp) { vmt = VMTS; S_all = 2560; } else { vmt = VMTP; S_all = 256; }
#pragma unroll
          for (int g = 0; g < 4; ++g) {
            const f32x4 q = *(const f32x4*)(ssq + R0 + 8 * g + 4 * h);
#pragma unroll
            for (int j = 0; j < 4; ++j) {
              const float sj = rsqrtf(q[j] * (1.f / 256.f) + 1e-6f);
              acc[mi][0][4 * g + j] *= sj; acc[mi][1][4 * g + j] *= sj;
            }
          }
        } else {
          const int lc = R0 >> 10; b = (R0 >> 9) & 1; s0 = 2048 + (R0 & 511);
          vmt = VMTS + (size_t)lc * N_VMTS; S_all = 2560;
        }
#pragma unroll
        for (int ni = 0; ni < 2; ++ni) {
          const int nt = nb + ni * 32, hh = nt >> 7, dv = (nt & 127) - 64 + r;
          ST_TILE32(vmt + (((size_t)b * 8 + hh) * 64 + dv) * S_all + s0, h, acc[mi][ni], 1.f);
        }
      }
      return;
    }
#pragma unroll
    for (int mi = 0; mi < 2; ++mi) {
      const int R = tb + mi * 32 + r;
      bf16_t *km, *vmt; int b, s, S_all; float sc;
      if (mode == 0) {
        bool smp; tok_decode(R, smp, b, s); sc = rsqrtf(ssq[R] * (1.f / 256.f) + 1e-6f);
        if (smp) { km = KMS; vmt = VMTS; S_all = 2560; } else { km = KMP; vmt = VMTP; S_all = 256; }
      } else {
        const int lc = R >> 10; b = (R >> 9) & 1; s = 2048 + (R & 511); sc = 1.f;
        km = KMS + (size_t)lc * N_KMS; vmt = VMTS + (size_t)lc * N_VMTS; S_all = 2560;
      }
#pragma unroll
      for (int ni = 0; ni < 2; ++ni) {
        const int nt = nb + ni * 32; const f32x16 v = acc[mi][ni];
        const int hh = nt >> 7, e0 = nt & 127;
        if (e0 < 64) {
          ST_TILE32(km + (((size_t)b * 8 + hh) * S_all + s) * 96 + e0, h, v, sc);
        } else {
          bf16_t* d = vmt + (((size_t)b * 8 + hh) * 64 + (e0 - 64) + 4 * h) * S_all + s;
#pragma unroll
          for (int g = 0; g < 4; ++g)
#pragma unroll
            for (int j = 0; j < 4; ++j) d[(size_t)(8 * g + j) * S_all] = f2bf(v[4 * g + j] * sc);
        }
      }
    }
  }
};

struct EpiRes {
  const float* xp; const float* xs; float* xz; const float* gate;
  DI void operator()(f32x16 (&acc)[2][2], int tb, int nb, int r, int h) const {
#pragma unroll
    for (int mi = 0; mi < 2; ++mi) {
      const int T = tb + mi * 32 + r;
      const int vi = T < NPR ? 0 : 1 + ((T - NPR) >> 11);
      const float* xr = T < NPR ? xp + (size_t)T * 1024 : xs + (size_t)(T - NPR) * 1024;
      const float* gp = gate + vi * 6144;
      float* zo = xz + (size_t)T * 1024;
#pragma unroll
      for (int ni = 0; ni < 2; ++ni) {
        const f32x16 v = acc[mi][ni];
#pragma unroll
        for (int g = 0; g < 4; ++g) {
          const int n = nb + ni * 32 + 8 * g + 4 * h;
          const f32x4 x = *(const f32x4*)(xr + n), gg = *(const f32x4*)(gp + n);
          f32x4 z = {ALPHA * x[0] + gg[0] * v[4 * g], ALPHA * x[1] + gg[1] * v[4 * g + 1], ALPHA * x[2] + gg[2] * v[4 * g + 2], ALPHA * x[3] + gg[3] * v[4 * g + 3]};
          *(f32x4*)(zo + n) = z;
        }
      }
    }
  }
};


struct EpiResLN {
  const float* xp; const float* xs; float* xout; bf16_t* Hout; const float* gate; const float* lng; const float* lnb; const float* modsh;
  unsigned long long* exch; unsigned* cnt; char* smem; int mt, nt;
  DI void operator()(f32x16 (&acc)[2][2], int tb, int nb, int r, int h) const {
    const int tid = my_tid();
    float* part = (float*)(smem + 65536);
    float* stat = (float*)(smem + 65536 + 2048);
    const int wm = (tb >> 6) & 1, wn = (nb >> 6) & 1;
    const int vi_t = tb < NPR ? 0 : 1 + ((tb - NPR) >> 11);
    {
      f32x4 gg[2][4];
      const float* gp = gate + vi_t * 6144 + nb + 4 * h;
#pragma unroll
      for (int ni = 0; ni < 2; ++ni)
#pragma unroll
        for (int g = 0; g < 4; ++g) gg[ni][g] = *(const f32x4*)(gp + ni * 32 + 8 * g);
#pragma unroll
      for (int mi = 0; mi < 2; ++mi) {
        const int T = tb + mi * 32 + r;
        const float* xr = (T < NPR ? xp + (size_t)T * 1024 : xs + (size_t)(T - NPR) * 1024) + nb + 4 * h;
        f32x4 xv[2][4];
#pragma unroll
        for (int ni = 0; ni < 2; ++ni)
#pragma unroll
          for (int g = 0; g < 4; ++g) xv[ni][g] = *(const f32x4*)(xr + ni * 32 + 8 * g);
        float s1 = 0.f, s2 = 0.f;
#pragma unroll
        for (int ni = 0; ni < 2; ++ni)
#pragma unroll
          for (int g = 0; g < 4; ++g)
#pragma unroll
            for (int j = 0; j < 4; ++j) { const float z = ALPHA * xv[ni][g][j] + gg[ni][g][j] * acc[mi][ni][4 * g + j]; acc[mi][ni][4 * g + j] = z; s1 += z; s2 += z * z; }
        s1 = xor32_sum(s1); s2 = xor32_sum(s2);
        if (h == 0) { const int row = wm * 64 + mi * 32 + r; part[(wn * 128 + row) * 2] = s1; part[(wn * 128 + row) * 2 + 1] = s2; }
      }
    }
    __syncthreads();
    if (tid < 128) {
      const float a = part[tid * 2] + part[(128 + tid) * 2], b = part[tid * 2 + 1] + part[(128 + tid) * 2 + 1];
      const unsigned long long pk = ((unsigned long long)__float_as_uint(b) << 32) | (unsigned long long)__float_as_uint(a);
      __hip_atomic_store(exch + ((size_t)mt * 8 + nt) * 128 + tid, pk, __ATOMIC_RELAXED, __HIP_MEMORY_SCOPE_AGENT);
    }
    asm volatile("s_waitcnt vmcnt(0)" ::: "memory");
    __syncthreads();
    if (tid == 0) {
      __hip_atomic_fetch_add(cnt + 64 * mt, 1u, __ATOMIC_RELAXED, __HIP_MEMORY_SCOPE_AGENT);
      unsigned sp = 0;
      while (__hip_atomic_load(cnt + 64 * mt, __ATOMIC_RELAXED, __HIP_MEMORY_SCOPE_AGENT) < 8u) { __builtin_amdgcn_s_sleep(1); if (++sp > (1u << 22)) break; }
    }
    __syncthreads();
    if (tid < 128) {
      float a = 0.f, b = 0.f;
#pragma unroll
      for (int q = 0; q < 8; ++q) {
        const unsigned long long pk = __hip_atomic_load(exch + ((size_t)mt * 8 + q) * 128 + tid, __ATOMIC_RELAXED, __HIP_MEMORY_SCOPE_AGENT);
        a += __uint_as_float((unsigned)pk); b += __uint_as_float((unsigned)(pk >> 32));
      }
      const float mean = a * (1.f / 1024.f);
      const float var = fmaxf(b * (1.f / 1024.f) - mean * mean, 0.f);
      stat[tid * 2] = mean; stat[tid * 2 + 1] = rsqrtf(var + 1e-5f);
    }
    __syncthreads();
    {
      const float* mp = modsh + vi_t * 6144 + nb + 4 * h;
      float mean[2], rstd[2];
#pragma unroll
      for (int mi = 0; mi < 2; ++mi) { const int row = wm * 64 + mi * 32 + r; mean[mi] = stat[row * 2]; rstd[mi] = stat[row * 2 + 1]; }
#pragma unroll
      for (int ni = 0; ni < 2; ++ni) {
        f32x4 gg[4], bv[4], sh[4], sc[4];
#pragma unroll
        for (int g = 0; g < 4; ++g) {
          gg[g] = *(const f32x4*)(lng + nb + 4 * h + ni * 32 + 8 * g); bv[g] = *(const f32x4*)(lnb + nb + 4 * h + ni * 32 + 8 * g);
          if (Hout) { sh[g] = *(const f32x4*)(mp + ni * 32 + 8 * g); sc[g] = *(const f32x4*)(mp + 1024 + ni * 32 + 8 * g); }
        }
#pragma unroll
        for (int mi = 0; mi < 2; ++mi) {
          const int T = tb + mi * 32 + r;
          float hv[16];
#pragma unroll
          for (int g = 0; g < 4; ++g) {
            const int n = nb + ni * 32 + 8 * g + 4 * h;
            f32x4 x;
#pragma unroll
            for (int j = 0; j < 4; ++j) x[j] = (acc[mi][ni][4 * g + j] - mean[mi]) * rstd[mi] * gg[g][j] + bv[g][j];
            *(f32x4*)(xout + (size_t)T * 1024 + n) = x;
            if (Hout) {
#pragma unroll
              for (int j = 0; j < 4; ++j) hv[4 * g + j] = x[j] * (sc[g][j] + 1.f) + sh[g][j];
            }
          }
          if (Hout) ST_TILE32(Hout + (size_t)T * 1024 + nb + ni * 32, h, hv, 1.f);
        }
      }
    }
  }
};

struct EpiFfUp {
  bf16_t* ACT;
  DI void operator()(f32x16 (&acc)[2][2], int tb, int nb, int r, int h) const {
#pragma unroll
    for (int mi = 0; mi < 2; ++mi) {
      const int T = tb + mi * 32 + r;
      float o[16];
#pragma unroll
      for (int i = 0; i < 16; ++i) { const float ga = acc[mi][0][i], up = acc[mi][1][i]; o[i] = ga * up * __builtin_amdgcn_rcpf(1.f + __builtin_amdgcn_exp2f(-LOG2E * ga)); }
      ST_TILE32(ACT + (size_t)T * DFF + (nb >> 1), h, o, 1.f);
    }
  }
};

template <bool LN>
DI void ln_mod_pass(const float* sp, const float* ss, float* xdst, bf16_t* hdst, const float* g, const float* bb, const float* mod_sh  ) {
  const int tid_ = my_tid(); const int lane = tid_ & 63, w = tid_ >> 6;
  for (int T = blockIdx.x * 4 + w; T < NTOK; T += gridDim.x * 4) {
    const float* src = T < NPR ? sp + (size_t)T * 1024 : ss + (size_t)(T - NPR) * 1024;
    f32x4 v[4];
#pragma unroll
    for (int i = 0; i < 4; ++i) v[i] = *(const f32x4*)(src + lane * 4 + 256 * i);
    if (LN) {
      float s = 0.f;
#pragma unroll
      for (int i = 0; i < 4; ++i) s += (v[i][0] + v[i][1]) + (v[i][2] + v[i][3]);
#pragma unroll
      for (int o = 32; o >= 1; o >>= 1) s += __shfl_xor(s, o);
      const float mu = s * (1.f / 1024.f);
      float q = 0.f;
#pragma unroll
      for (int i = 0; i < 4; ++i) { v[i] = v[i] - mu; q += (v[i][0] * v[i][0] + v[i][1] * v[i][1]) + (v[i][2] * v[i][2] + v[i][3] * v[i][3]); }
#pragma unroll
      for (int o = 32; o >= 1; o >>= 1) q += __shfl_xor(q, o);
      const float rstd = rsqrtf(q * (1.f / 1024.f) + 1e-5f);
#pragma unroll
      for (int i = 0; i < 4; ++i) {
        const f32x4 gg = *(const f32x4*)(g + lane * 4 + 256 * i), bv = *(const f32x4*)(bb + lane * 4 + 256 * i);
        v[i] = v[i] * rstd * gg + bv;
        *(f32x4*)(xdst + (size_t)T * 1024 + lane * 4 + 256 * i) = v[i];
      }
    }
    if (hdst) {
      const int vi = T < NPR ? 0 : 1 + ((T - NPR) >> 11);
      const float* mp = mod_sh + vi * 6144;
#pragma unroll
      for (int i = 0; i < 4; ++i) {
        const f32x4 sh = *(const f32x4*)(mp + lane * 4 + 256 * i), sc = *(const f32x4*)(mp + 1024 + lane * 4 + 256 * i);
        const f32x4 o = v[i] * (sc + 1.f) + sh;
        st4bf(hdst + (size_t)T * 1024 + lane * 4 + 256 * i, o[0], o[1], o[2], o[3]);
      }
    }
  }
}

template <int MODE>
DI void attn_unit(const bf16_t* __restrict__ Q, size_t qmap, const bf16_t* __restrict__ Kg, size_t kmap, const bf16_t* __restrict__ VT, int S_all, int nkeys,
                  bf16_t* __restrict__ Yout, float lam, const float* __restrict__ normw, float oscale, char* smem,
                  float* ows_pair, unsigned* flag, int mapidx, int* s_flag) {
  constexpr bool DIFF = MODE == 1, D32 = MODE != 0;
  constexpr int DQK = D32 ? 32 : 96, NKS = DQK / 16, NMAP = DIFF ? 2 : 1, KROWB = D32 ? 80 : 208;
  constexpr int KREG = NMAP * 64 * KROWB, STAGE = 24576, KCH = DQK / 8  , NKLD = NMAP * 64 * KCH / 256;
  const int tid = my_tid(), lane = tid & 63, w = tid >> 6, r = lane & 31, h = lane >> 5;
  bf16x8 qf[NMAP][NKS];
#pragma unroll
  for (int m = 0; m < NMAP; ++m)
#pragma unroll
    for (int ks = 0; ks < NKS; ++ks) qf[m][ks] = *(const bf16x8*)(Q + m * qmap + (size_t)(w * 32 + r) * DQK + ks * 16 + 8 * h);
#pragma unroll
  for (int m = 0; m < NMAP; ++m)
#pragma unroll
    for (int ks = 0; ks < NKS; ++ks) asm volatile("" :: "v"(qf[m][ks]));
  f32x16 O[NMAP][2];
  float mrun[NMAP], lrun[NMAP];
#pragma unroll
  for (int m = 0; m < NMAP; ++m) { mrun[m] = -1e30f; lrun[m] = 0.f;
#pragma unroll
    for (int dt = 0; dt < 2; ++dt)
#pragma unroll
      for (int i = 0; i < 16; ++i) O[m][dt][i] = 0.f; }
  u32x4 rk[NKLD], rv[2];
  const int vdv = tid >> 3, vch = tid & 7;
#define ATT_GLOAD(key0) do { \
    _Pragma("unroll") for (int i = 0; i < NKLD; ++i) { const int idx = tid + 256 * i; int go; \
      if (D32) { go = ((idx >> 2) & 63) * 32 + (idx & 3) * 8; } else { const int row = idx / 12; go = row * 96 + (idx - row * 12) * 8; } \
      rk[i] = *(const u32x4*)(Kg + (DIFF ? (size_t)i * kmap : 0) + (size_t)(key0) * DQK + go); } \
    _Pragma("unroll") for (int i = 0; i < 2; ++i) rv[i] = *(const u32x4*)(VT + (size_t)(vdv + 32 * i) * S_all + (key0) + vch * 8); } while (0)
#define ATT_SWRITE(st) do { char* base_ = smem + (st) * STAGE; \
    _Pragma("unroll") for (int i = 0; i < NKLD; ++i) { const int idx = tid + 256 * i; int so; \
      if (D32) { so = i * 64 * KROWB + ((idx >> 2) & 63) * KROWB + (idx & 3) * 16; } else { const int row = idx / 12; so = row * KROWB + (idx - row * 12) * 16; } \
      *(u32x4*)(base_ + so) = rk[i]; } \
    _Pragma("unroll") for (int i = 0; i < 2; ++i) { char* d_ = base_ + KREG + (vdv + 32 * i) * 136 + vch * 16; \
      u32x2 lo_ = {rv[i][0], rv[i][1]}, hi_ = {rv[i][2], rv[i][3]}; *(u32x2*)d_ = lo_; *(u32x2*)(d_ + 8) = hi_; } } while (0)
  ATT_GLOAD(0); ATT_SWRITE(0); __syncthreads();
  const int nt = nkeys >> 6;
  for (int t = 0; t < nt; ++t) {
    const char* cur = smem + (t & 1) * STAGE;
    if (t + 1 < nt) ATT_GLOAD((t + 1) * 64);
#pragma unroll
    for (int m = 0; m < NMAP; ++m) {
      f32x16 S[2];
#pragma unroll
      for (int kt = 0; kt < 2; ++kt)
#pragma unroll
        for (int i = 0; i < 16; ++i) S[kt][i] = 0.f;
      {
        bf16x8 kf[NKS][2];
#pragma unroll
        for (int kt = 0; kt < 2; ++kt) kf[0][kt] = *(const bf16x8*)(cur + m * 64 * KROWB + (kt * 32 + r) * KROWB + (8 * h) * 2);
#pragma unroll
        for (int ks = 0; ks < NKS; ++ks) {
          if (ks + 1 < NKS) {
#pragma unroll
            for (int kt = 0; kt < 2; ++kt) kf[ks + 1][kt] = *(const bf16x8*)(cur + m * 64 * KROWB + (kt * 32 + r) * KROWB + ((ks + 1) * 16 + 8 * h) * 2);
          }
          __builtin_amdgcn_sched_barrier(0);
#pragma unroll
          for (int kt = 0; kt < 2; ++kt) S[kt] = MFMA(kf[ks][kt], qf[m][ks], S[kt]);
          __builtin_amdgcn_sched_barrier(0);
        }
      }
      float mx = S[0][0];
#pragma unroll
      for (int kt = 0; kt < 2; ++kt)
#pragma unroll
        for (int i = 0; i < 16; ++i) mx = fmaxf(mx, S[kt][i]);
      mx = xor32_max(mx);
      const float mnew = fmaxf(mrun[m], mx);
      const float alpha = __builtin_amdgcn_exp2f(mrun[m] - mnew);
      mrun[m] = mnew;
      f32x2 ls2 = {0.f, 0.f};
      const f32x2 mneg = {-mnew, -mnew};
      bf16x8 pf[2][2];
#pragma unroll
      for (int kt = 0; kt < 2; ++kt) {
        unsigned pk[8];
#pragma unroll
        for (int i = 0; i < 8; ++i) {
          f32x2 v = {S[kt][2 * i], S[kt][2 * i + 1]};
          v = v + mneg;
          v.x = __builtin_amdgcn_exp2f(v.x); v.y = __builtin_amdgcn_exp2f(v.y);
          ls2 = ls2 + v;
          pk[i] = pack2(v.x, v.y);
        }
#pragma unroll
        for (int s2 = 0; s2 < 2; ++s2) {
          u32x4 pq = {pk[4 * s2], pk[4 * s2 + 1], pk[4 * s2 + 2], pk[4 * s2 + 3]};
          pf[kt][s2] = __builtin_bit_cast(bf16x8, pq);
        }
      }
      const float ls = ls2.x + ls2.y;
      lrun[m] = lrun[m] * alpha + ls;
#pragma unroll
      for (int dt = 0; dt < 2; ++dt)
#pragma unroll
        for (int i = 0; i < 16; ++i) O[m][dt][i] *= alpha;
#pragma unroll
      for (int kt = 0; kt < 2; ++kt)
#pragma unroll
        for (int s2 = 0; s2 < 2; ++s2) {
          bf16x8 vf[2];
#pragma unroll
          for (int dt = 0; dt < 2; ++dt) {
            const char* a = cur + KREG + (dt * 32 + r) * 136 + (kt * 32 + 16 * s2 + 4 * h) * 2;
            const s16x4 lo = *(const s16x4*)a, hi = *(const s16x4*)(a + 16);
            vf[dt] = __builtin_shufflevector(lo, hi, 0, 1, 2, 3, 4, 5, 6, 7);
          }
#pragma unroll
          for (int dt = 0; dt < 2; ++dt) O[m][dt] = MFMA(vf[dt], pf[kt][s2], O[m][dt]);
        }
      if (NMAP == 2) __builtin_amdgcn_sched_barrier(0);
    }
    if (t + 1 < nt) ATT_SWRITE((t + 1) & 1);
    __syncthreads();
  }
#undef ATT_GLOAD
#undef ATT_SWRITE
  float linv[NMAP];
#pragma unroll
  for (int m = 0; m < NMAP; ++m) { const float lt = lrun[m] + __shfl_xor(lrun[m], 32); linv[m] = 1.f / lt; }
  bf16_t* yo = Yout + (size_t)(w * 32 + r) * 1024 + 4 * h;
  if (MODE == 2) {
    float* mine = ows_pair + ((size_t)mapidx * 128 + w * 32 + r) * 64 + 4 * h;
#pragma unroll
    for (int dt = 0; dt < 2; ++dt)
#pragma unroll
      for (int g = 0; g < 4; ++g) {
        f32x4 o = {O[0][dt][4 * g] * linv[0], O[0][dt][4 * g + 1] * linv[0], O[0][dt][4 * g + 2] * linv[0], O[0][dt][4 * g + 3] * linv[0]};
#pragma unroll
        for (int j = 0; j < 4; ++j) O[0][dt][4 * g + j] = o[j];
        *(f32x4*)(mine + dt * 32 + 8 * g) = o;
      }
    asm volatile("s_waitcnt vmcnt(0)" ::: "memory");
    __syncthreads();
    if (tid == 0) {
      __builtin_amdgcn_fence(__ATOMIC_RELEASE, "agent");
      asm volatile("s_waitcnt vmcnt(0)" ::: "memory");
      const unsigned old = __hip_atomic_fetch_add(flag, 1u, __ATOMIC_RELAXED, __HIP_MEMORY_SCOPE_AGENT);
      if (old == 1u) { __builtin_amdgcn_fence(__ATOMIC_ACQUIRE, "agent"); asm volatile("s_waitcnt vmcnt(0)" ::: "memory"); }
      *s_flag = (int)old;
    }
    __syncthreads();
    if (*s_flag == 1) {
      const float* oth = ows_pair + ((size_t)(1 - mapidx) * 128 + w * 32 + r) * 64 + 4 * h;
      const float c_mine = mapidx == 0 ? 1.f : -lam, c_oth = mapidx == 0 ? -lam : 1.f;
      float ssq = 0.f;
#pragma unroll
      for (int dt = 0; dt < 2; ++dt)
#pragma unroll
        for (int g = 0; g < 4; ++g) {
          const f32x4 po = *(const f32x4*)(oth + dt * 32 + 8 * g);
#pragma unroll
          for (int j = 0; j < 4; ++j) { const float o = c_mine * O[0][dt][4 * g + j] + c_oth * po[j]; O[0][dt][4 * g + j] = o; ssq += o * o; }
        }
      ssq = xor32_sum(ssq);
      const float rn = rsqrtf(ssq * (1.f / 64.f) + 1e-6f) * oscale;
#pragma unroll
      for (int dt = 0; dt < 2; ++dt) {
#pragma unroll
        for (int g = 0; g < 4; ++g) {
          const f32x4 nw = *(const f32x4*)(normw + dt * 32 + 8 * g + 4 * h);
#pragma unroll
          for (int j = 0; j < 4; ++j) O[0][dt][4 * g + j] *= rn * nw[j];
        }
        ST_TILE32(yo - 4 * h + dt * 32, h, O[0][dt], 1.f);
      }
    }
  } else if (DIFF) {
    float ssq = 0.f;
#pragma unroll
    for (int dt = 0; dt < 2; ++dt)
#pragma unroll
      for (int i = 0; i < 16; ++i) { const float o = O[0][dt][i] * linv[0] - lam * (O[NMAP - 1][dt][i] * linv[NMAP - 1]); O[0][dt][i] = o; ssq += o * o; }
    ssq = xor32_sum(ssq);
    const float rn = rsqrtf(ssq * (1.f / 64.f) + 1e-6f) * oscale;
#pragma unroll
    for (int dt = 0; dt < 2; ++dt) {
#pragma unroll
      for (int g = 0; g < 4; ++g) {
        const f32x4 nw = *(const f32x4*)(normw + dt * 32 + 8 * g + 4 * h);
#pragma unroll
        for (int j = 0; j < 4; ++j) O[0][dt][4 * g + j] *= rn * nw[j];
      }
      ST_TILE32(yo - 4 * h + dt * 32, h, O[0][dt], 1.f);
    }
  } else {
#pragma unroll
    for (int dt = 0; dt < 2; ++dt) ST_TILE32(yo - 4 * h + dt * 32, h, O[0][dt], linv[0]);
  }
}


#define XB_TMO      128
#define XB_XCNT(j)  (256  + 64 * (j))
#define XB_XSUB(j)  (1280 + 64 * (j))
#define XB_XGEN(j)  (2304 + 64 * (j))
#define XB_TOP      3328
#define XB_TOPGEN   3392
#define XCD_BAR_WORDS 3456
#define XB_SPIN_CAP (1u << 18)
#define LAS __attribute__((address_space(3)))
DI unsigned xb_ld(unsigned* p)              { return __hip_atomic_load(p, __ATOMIC_RELAXED, __HIP_MEMORY_SCOPE_AGENT); }
DI unsigned xb_add(unsigned* p, unsigned v) { return __hip_atomic_fetch_add(p, v, __ATOMIC_RELAXED, __HIP_MEMORY_SCOPE_AGENT); }
DI unsigned xb_xcc_id() { return (unsigned)__builtin_amdgcn_s_getreg((3 << 11) | 20) & 0xFu; }
#define XB_SPIN(cond, bar) do { unsigned _sp = 0; while (cond) { __builtin_amdgcn_s_sleep(1); \
    if ((++_sp & 255u) == 0u) { if (xb_ld(&(bar)[XB_TMO])) break; if (_sp > XB_SPIN_CAP) { atomicAdd(&(bar)[XB_TMO], 1u); break; } } } } while (0)
struct XcdBarrier { unsigned* bar; unsigned x; volatile LAS unsigned* st; };
DI XcdBarrier xcd_barrier_post(unsigned* bar, volatile LAS unsigned* st) {
  XcdBarrier b; b.bar = bar; b.x = xb_xcc_id(); b.st = st;
  if (threadIdx.x == 0) (void)xb_add(&bar[XB_XCNT(b.x)], 1u);
  return b;
}
DI void xcd_barrier_complete(unsigned* bar, unsigned x, unsigned& nloc, unsigned& nx) {
  const unsigned G = gridDim.x * gridDim.y * gridDim.z;
  unsigned sum, cnt, mine, sp = 0u;
  for (;;) {
    sum = 0u; cnt = 0u; mine = 0u;
#pragma unroll
    for (unsigned j = 0; j < 16; ++j) { const unsigned c = xb_ld(&bar[XB_XCNT(j)]); sum += c; cnt += (c > 0u) ? 1u : 0u; mine = (j == x) ? c : mine; }
    if (sum == G) break;
    __builtin_amdgcn_s_sleep(1);
    if ((++sp & 255u) == 0u) { if (xb_ld(&bar[XB_TMO])) break; if (sp > XB_SPIN_CAP) { atomicAdd(&bar[XB_TMO], 1u); break; } }
  }
  nloc = mine > 0u ? mine : 1u; nx = cnt > 0u ? cnt : 1u;
}
DI void xcd_barrier(const XcdBarrier& b) {
  asm volatile("s_waitcnt vmcnt(0)" ::: "memory");
  __syncthreads();
  if (threadIdx.x == 0) {
    unsigned* bar = b.bar;
    __builtin_amdgcn_s_waitcnt(0);
    unsigned nloc = b.st[0], nx = b.st[1];
    if (nloc == 0u) { xcd_barrier_complete(bar, b.x, nloc, nx); b.st[0] = nloc; b.st[1] = nx; }
    const unsigned old = xb_add(&bar[XB_XSUB(b.x)], 1u);
    const unsigned gen = old / nloc;
    if (old + 1u == (gen + 1u) * nloc) {
      __builtin_amdgcn_fence(__ATOMIC_RELEASE, "agent");
      asm volatile("s_waitcnt vmcnt(0)" ::: "memory");
      const unsigned og = xb_add(&bar[XB_TOP], 1u);
      const unsigned tg = og / nx;
      if (og + 1u == (tg + 1u) * nx) xb_add(&bar[XB_TOPGEN], 1u);
      else XB_SPIN(xb_ld(&bar[XB_TOPGEN]) == tg, bar);
      __builtin_amdgcn_fence(__ATOMIC_ACQUIRE, "agent");
      xb_add(&bar[XB_XGEN(b.x)], 1u);
      asm volatile("s_waitcnt vmcnt(0)" ::: "memory");
    } else {
      XB_SPIN(xb_ld(&bar[XB_XGEN(b.x)]) == gen, bar);
      __builtin_amdgcn_fence(__ATOMIC_ACQUIRE, "agent");
      asm volatile("s_waitcnt vmcnt(0)" ::: "memory");
    }
  }
  __syncthreads();
}

DI void transpose_tile(const float* __restrict__ src, int ldn, int nvalid, bf16_t* __restrict__ dst, int K, const float* __restrict__ rowscale, int mode, int kt, int nt, float* tile) {
  const int tid = my_tid();
  {
    const int c4 = tid & 63, r0 = tid >> 6;
    const int n = nt * 256 + c4 * 4;
    f32x4 v[16];
#pragma unroll
    for (int i = 0; i < 16; ++i) {
      const int k = kt * 64 + r0 + 4 * i;
      v[i] = (f32x4){0.f, 0.f, 0.f, 0.f};
      if (n < nvalid) v[i] = __builtin_nontemporal_load((const f32x4*)(src + (size_t)k * ldn + n));
    }
#pragma unroll
    for (int i = 0; i < 16; ++i) {
      const int kl = r0 + 4 * i;
      f32x4 x = v[i];
      if (rowscale) { const float sc = rowscale[kt * 64 + kl]; x = x * sc; }
      float* t = tile + kl * 257 + c4 * 4;
      t[0] = x[0]; t[1] = x[1]; t[2] = x[2]; t[3] = x[3];
    }
  }
  __syncthreads();
  {
    const int q = tid & 7, nr = tid >> 3;
#pragma unroll
    for (int i = 0; i < 8; ++i) {
      const int nl = nr + 32 * i, n = nt * 256 + nl;
      int drow = n;
      if (mode == 1) drow = (n >> 5) * 64 + (n & 31);
      else if (mode == 2) drow = (n >> 5) * 64 + 32 + (n & 31);
      float v[8];
#pragma unroll
      for (int j = 0; j < 8; ++j) v[j] = tile[(q * 8 + j) * 257 + nl];
      u32x4 a = {pack2(v[0], v[1]), pack2(v[2], v[3]), pack2(v[4], v[5]), pack2(v[6], v[7])};
      *(u32x4*)(dst + (size_t)drow * K + kt * 64 + q * 8) = a;
    }
  }
  __syncthreads();
}

DI void adaln_task(const Params& p, int l, int kc, float* PART, float* sm, unsigned* done) {
  const int tid = my_tid();
  if (tid < 48) {
    const int v = tid >> 4, k = kc * 16 + (tid & 15);
    const float x = v == 0 ? p.c_ctx[k] : p.c[(v - 1) * 1024 + k];
    sm[tid] = x / (1.f + __expf(-x));
  }
  __syncthreads();
  f32x4 a0[6], a1[6], a2[6];
#pragma unroll
  for (int i = 0; i < 6; ++i) { a0[i] = (f32x4){0.f, 0.f, 0.f, 0.f}; a1[i] = a0[i]; a2[i] = a0[i]; }
  const float* wp = p.w_ada + (size_t)l * 1024 * 6144 + (size_t)(kc * 16) * 6144 + tid * 4;
#pragma unroll 4
  for (int kk = 0; kk < 16; ++kk) {
    f32x4 w[6];
#pragma unroll
    for (int i = 0; i < 6; ++i) w[i] = __builtin_nontemporal_load((const f32x4*)(wp + (size_t)kk * 6144 + i * 1024));
    const float s0 = sm[kk], s1 = sm[16 + kk], s2 = sm[32 + kk];
#pragma unroll
    for (int i = 0; i < 6; ++i) { a0[i] += w[i] * s0; a1[i] += w[i] * s1; a2[i] += w[i] * s2; }
  }
  float* m0 = PART + (((size_t)l * 64 + kc) * 3) * 6144 + tid * 4;
#pragma unroll
  for (int i = 0; i < 6; ++i) {
    *(f32x4*)(m0 + i * 1024) = a0[i];
    *(f32x4*)(m0 + 6144 + i * 1024) = a1[i];
    *(f32x4*)(m0 + 2 * 6144 + i * 1024) = a2[i];
  }
  asm volatile("s_waitcnt vmcnt(0)" ::: "memory");
  __syncthreads();
  if (tid == 0) {
    __builtin_amdgcn_fence(__ATOMIC_RELEASE, "agent");
    asm volatile("s_waitcnt vmcnt(0)" ::: "memory");
    __hip_atomic_fetch_add(done + l, 1u, __ATOMIC_RELAXED, __HIP_MEMORY_SCOPE_AGENT);
  }
}

DI void adaln_reduce(const Params& p, int chunk, const float* PART, float* MOD, unsigned* done, int rep) {
  const int tid = my_tid();
  const int l = chunk / 72, rem = chunk - l * 72, v = rem / 24, col = (rem - v * 24) * 256 + tid;
  if (tid == 0) {
    unsigned sp = 0;
    while (__hip_atomic_load(done + l, __ATOMIC_RELAXED, __HIP_MEMORY_SCOPE_AGENT) < 64u * (unsigned)(rep + 1)) { __builtin_amdgcn_s_sleep(2); if (++sp > (1u << 22)) break; }
    __builtin_amdgcn_fence(__ATOMIC_ACQUIRE, "agent");
    asm volatile("s_waitcnt vmcnt(0)" ::: "memory");
  }
  __syncthreads();
  const float* pp = PART + ((size_t)l * 64 * 3 + v) * 6144 + col;
  float s0 = 0.f, s1 = 0.f, s2 = 0.f, s3 = 0.f;
#pragma unroll 4
  for (int kc = 0; kc < 64; kc += 4) {
    s0 += pp[(size_t)(kc + 0) * 3 * 6144]; s1 += pp[(size_t)(kc + 1) * 3 * 6144]; s2 += pp[(size_t)(kc + 2) * 3 * 6144]; s3 += pp[(size_t)(kc + 3) * 3 * 6144];
  }
  MOD[((size_t)l * 3 + v) * 6144 + col] = (s0 + s1) + (s2 + s3) + p.b_ada[l * 6144 + col];
}

__global__ void __launch_bounds__(256, 2) mega(Params p) {
  __shared__ __attribute__((aligned(16))) char smem[SMEM_BYTES];
  __shared__ int s_unit;
  __shared__ int s_flag;
  cg::grid_group grid = cg::this_grid();
  if (p.ws == nullptr) grid.sync();
  __shared__ uint4 xb_words;
  if (threadIdx.x == 0) xb_words = make_uint4(0u, 0u, 0u, 0u);
  __syncthreads();
  const XcdBarrier xbar = xcd_barrier_post((unsigned*)(p.ws + O_BAR), (volatile LAS unsigned*)&xb_words);
#define GSYNC() xcd_barrier(xbar)
  int tid = threadIdx.x;
  char* ws = p.ws;
  bf16_t* WIN = (bf16_t*)(ws + O_WIN); bf16_t* WUQ = (bf16_t*)(ws + O_WUQ); bf16_t* WUKVN = (bf16_t*)(ws + O_WUKVN); bf16_t* WUKVC = (bf16_t*)(ws + O_WUKVC);
  bf16_t* WOUT = (bf16_t*)(ws + O_WOUT); bf16_t* W13 = (bf16_t*)(ws + O_W13); bf16_t* W2 = (bf16_t*)(ws + O_W2);
  bf16_t* H = (bf16_t*)(ws + O_H); bf16_t* DKP = (bf16_t*)(ws + O_DKP); bf16_t* DKS = (bf16_t*)(ws + O_DKS); bf16_t* DVTP = (bf16_t*)(ws + O_DVTP);
  bf16_t* DVTS = (bf16_t*)(ws + O_DVTS); bf16_t* KMP = (bf16_t*)(ws + O_KMP); bf16_t* KMS = (bf16_t*)(ws + O_KMS); bf16_t* VMTP = (bf16_t*)(ws + O_VMTP);
  bf16_t* VMTS = (bf16_t*)(ws + O_VMTS); bf16_t* CKVC = (bf16_t*)(ws + O_CKVC); float* MOD = (float*)(ws + O_MOD); float* CKVF = (float*)(ws + O_CKVF);
  float* XZ = (float*)(ws + O_XZ); int* CTR = (int*)(ws + O_CTR);
  bf16_t* AX = (bf16_t*)(ws + O_AX); bf16_t* DQ = (bf16_t*)(ws + O_DQ); bf16_t* CQ = (bf16_t*)(ws + O_CQ); bf16_t* CKVB = (bf16_t*)(ws + O_CKVB);
  bf16_t* QM = (bf16_t*)(ws + O_QM); bf16_t* Y = (bf16_t*)(ws + O_Y); bf16_t* ACT = (bf16_t*)(ws + O_ACT);
  const int G = gridDim.x, bid = blockIdx.x;

  for (int rep = 0; rep < REP_P0; ++rep) {
  for (int t = bid; t < 128 + 2 * 786; t += G) {
    if (t < 128) { adaln_task(p, t >> 6, t & 63, (float*)(ws + O_PART), (float*)smem, (unsigned*)(CTR + 4)); continue; }
    int u = t - 128; const int l = u / 786; u -= l * 786;
    float* tile = (float*)smem;
    if (u < 144) { transpose_tile(p.w_in + (size_t)l * 1024 * INC, INC, INC, WIN + (size_t)l * INP * 1024, 1024, nullptr, 0, u / 9, u % 9, tile); continue; }
    u -= 144;
    if (u < 18) { transpose_tile(p.w_uq + (size_t)l * 384 * 768, 768, 768, WUQ + (size_t)l * 768 * 384, 384, p.q_norm_w + l * 384, 0, u / 3, u % 3, tile); continue; }
    u -= 18;
    if (u < 16) { transpose_tile(p.w_ukv + (size_t)l * 256 * 1024, 1024, 1024, WUKVN + (size_t)l * 1024 * 256, 256, p.kv_norm_w + l * 256, 0, u / 4, u % 4, tile); continue; }
    u -= 16;
    if (u < 16) { transpose_tile(p.w_ukv + (size_t)l * 256 * 1024, 1024, 1024, WUKVC + (size_t)l * 1024 * 256, 256, nullptr, 0, u / 4, u % 4, tile); continue; }
    u -= 16;
    if (u < 64) { transpose_tile(p.w_out + (size_t)l * 1024 * 1024, 1024, 1024, WOUT + (size_t)l * 1024 * 1024, 1024, nullptr, 0, u / 4, u % 4, tile); continue; }
    u -= 64;
    if (u < 176) { transpose_tile(p.w_ff1 + (size_t)l * 1024 * DFF, DFF, DFF, W13 + (size_t)l * 5632 * 1024, 1024, nullptr, 1, u / 11, u % 11, tile); continue; }
    u -= 176;
    if (u < 176) { transpose_tile(p.w_ff3 + (size_t)l * 1024 * DFF, DFF, DFF, W13 + (size_t)l * 5632 * 1024, 1024, nullptr, 2, u / 11, u % 11, tile); continue; }
    u -= 176;
    transpose_tile(p.w_ff2 + (size_t)l * DFF * 1024, 1024, 1024, W2 + (size_t)l * 1024 * DFF, DFF, nullptr, 0, u / 4, u % 4, tile);
  }
  {
    const int gt = bid * 256 + tid, gn = G * 256;
    for (int i8 = gt; i8 < 2 * 2 * 4 * 2 * 512 * 32 / 8; i8 += gn) {
      const int i = i8 * 8, d = i & 31, pp = (i >> 5) & 511, m = (i >> 14) & 1, hd = (i >> 15) & 3, l = (i >> 17) & 1, b = i >> 18;
      const f32x4 x0 = *(const f32x4*)(p.cache_k + i), x1 = *(const f32x4*)(p.cache_k + i + 4);
      u32x4 o = {pack2(x0[0], x0[1]), pack2(x0[2], x0[3]), pack2(x1[0], x1[1]), pack2(x1[2], x1[3])};
      *(u32x4*)(DKS + (size_t)l * N_DKS + ((((size_t)b * 4 + hd) * 2 + m) * 2560 + 2048 + pp) * 32 + d) = o;
    }
    for (int i8 = gt; i8 < 2 * 2 * 4 * 64 * 512 / 8; i8 += gn) {
      const int p8 = (i8 & 63) * 8, dv = (i8 >> 6) & 63, hd = (i8 >> 12) & 3, l = (i8 >> 14) & 1, b = i8 >> 15;
      const float* sp = p.cache_v + ((((size_t)b * 2 + l) * 4 + hd) * 512 + p8) * 64 + dv;
      float x[8];
#pragma unroll
      for (int j = 0; j < 8; ++j) x[j] = sp[j * 64];
      u32x4 o = {pack2(x[0], x[1]), pack2(x[2], x[3]), pack2(x[4], x[5]), pack2(x[6], x[7])};
      *(u32x4*)(DVTS + (size_t)l * N_DVTS + (((size_t)b * 4 + hd) * 64 + dv) * 2560 + 2048 + p8) = o;
    }
    for (int i8 = gt; i8 < 2 * 2 * 512 * 256 / 8; i8 += gn) {
      const int i = i8 * 8, cc = i & 255, pp = (i >> 8) & 511, l = (i >> 17) & 1, b = i >> 18;
      const f32x4 x0 = *(const f32x4*)(p.cache_ckv + i), x1 = *(const f32x4*)(p.cache_ckv + i + 4);
      u32x4 o = {pack2(x0[0], x0[1]), pack2(x0[2], x0[3]), pack2(x1[0], x1[1]), pack2(x1[2], x1[3])};
      *(u32x4*)(CKVC + (((size_t)l * 2 + b) * 512 + pp) * 256 + cc) = o;
    }
    for (int i8 = gt; i8 < 2 * 2 * 512 * 32 / 8; i8 += gn) {
      const int j = i8 * 8, d = j & 31, pp = (j >> 5) & 511, l = (j >> 14) & 1, b = j >> 15;
      const f32x4 x0 = *(const f32x4*)(p.cache_kpe + j), x1 = *(const f32x4*)(p.cache_kpe + j + 4);
      u32x4 o = {pack2(x0[0], x0[1]), pack2(x0[2], x0[3]), pack2(x1[0], x1[1]), pack2(x1[2], x1[3])};
      for (int hh = 0; hh < 8; ++hh) *(u32x4*)(KMS + (size_t)l * N_KMS + (((size_t)b * 8 + hh) * 2560 + 2048 + pp) * 96 + 64 + d) = o;
    }
  }
  for (int c = (G >= 144 ? bid - (G - 144) : bid); c < 144; c += G) if (c >= 0) adaln_reduce(p, c, (const float*)(ws + O_PART), MOD, (unsigned*)(CTR + 4), rep);
  GSYNC();
  }
  for (int rep = 0; rep < REP_SYNC; ++rep) GSYNC();

  ln_mod_pass<false>(p.x_prompt, p.x_sample, nullptr, H, nullptr, nullptr, MOD);
  GSYNC();

  for (int l = 0; l < 2; ++l) {
    const float* MODl = MOD + (size_t)l * 3 * 6144;
    float* SSQl = (float*)(ws + O_SSQ) + (size_t)l * 2 * 8192;
    bf16_t* DKSl = DKS + (size_t)l * N_DKS; bf16_t* DVTSl = DVTS + (size_t)l * N_DVTS; bf16_t* KMSl = KMS + (size_t)l * N_KMS; bf16_t* VMTSl = VMTS + (size_t)l * N_VMTS;
    for (int rep = 0; rep < REP_P1; ++rep) {
      EpiIn e{l, AX, DQ, DKP, DKSl, DVTP, DVTSl, CQ, CKVB, KMP, KMSl, CKVF, p.out, SSQl};
      const bf16_t* Bt = WIN + (size_t)l * INP * 1024;
      gemm_phase(H, 1024, Bt, 1024, 1024, (bid & 7) * 8, bid >> 3, 8 * 18, G >> 3, smem, e);
      if (l == 0 && rep == 0) {
        const int per = G >> 3, xq = bid >> 3, nt_x = 8 * 18, first = nt_x % per;
        const int nlight = per - first;
        for (int t = (xq - first) * 8 + (bid & 7); xq >= first && t < 128; t += nlight * 8) {
          const int mt = t >> 3, ntile = t & 7, lc = mt >> 3;
          EpiUkv e2{1, nullptr, nullptr, KMS, VMTS, nullptr};
          if (__builtin_amdgcn_readfirstlane(tid >> 7)) gemm_tile<1>(CKVC, 256, WUKVC + (size_t)lc * 1024 * 256, 256, 256, mt * 128, ntile * 128, smem, e2);
          else gemm_tile<0>(CKVC, 256, WUKVC + (size_t)lc * 1024 * 256, 256, 256, mt * 128, ntile * 128, smem, e2);
        }
      }
      GSYNC();
    }
#ifdef PROBE_P1NULL
    {
      EpiInT<PROBE_P1NULL> e{l, AX, DQ, DKP, DKSl, DVTP, DVTSl, CQ, CKVB, KMP, KMSl, CKVF, p.out, SSQl};
      const bf16_t* Bt = WIN + (size_t)l * INP * 1024;
      for (int t = bid; t < 64 * 18; t += G) gemm_tile(H, 1024, Bt, 1024, 1024, (t / 18) * 128, (t % 18) * 128, smem, e);
      GSYNC();
    }
#endif
    for (int rep = 0; rep < REP_P2; ++rep) {
    for (int j = bid >> 3; j < 8 * 14; j += G >> 3) {
      const int mt = (bid & 7) * 8 + (j & 7), nn = j >> 3;
      if (nn < 6) {
        EpiUq e{QM, SSQl};
        gemm_tile(CQ, 384, WUQ + (size_t)l * 768 * 384, 384, 384, mt * 128, nn * 128, smem, e);
      } else {
        const int ntile = nn - 6;
        if (ntile == 0 && mt < 32) {
          const float* kw = p.kv_norm_w + l * 256;
          for (int i = tid; i < 128 * 64; i += 256) {
            const int row = i >> 6, c4 = (i & 63) * 4, T = mt * 128 + row, b = T >> 8, s = T & 255;
            const float rsv = rsqrtf(SSQl[8192 + T] * (1.f / 256.f) + 1e-6f);
            const f32x4 v = *(const f32x4*)(CKVF + (size_t)T * 256 + c4), wv = *(const f32x4*)(kw + c4);
            *(f32x4*)(p.out + OUT_CKV + (((size_t)b * 2 + l) * 256 + s) * 256 + c4) = v * rsv * wv;
          }
        }
        EpiUkv e{0, KMP, VMTP, KMSl, VMTSl, SSQl + 8192};
        if (__builtin_amdgcn_readfirstlane(tid >> 7)) gemm_tile<1>(CKVB, 256, WUKVN + (size_t)l * 1024 * 256, 256, 256, mt * 128, ntile * 128, smem, e);
        else gemm_tile<0>(CKVB, 256, WUKVN + (size_t)l * 1024 * 256, 256, 256, mt * 128, ntile * 128, smem, e);
      }
    }
    {
      asm volatile("" : "+v"(tid));
      const float* cw = p.conv_w + l * 768;
      for (int i = bid * 256 + tid; i < NTOK * 32; i += G * 256) {
        const int T = i >> 5, c = (i & 31) * 8;
        bool smp; int b, s; tok_decode(T, smp, b, s);
        const int slen = smp ? 2048 : 256;
        const bf16_t* row = AX + (size_t)T * 768;
        float u0[8], u1[8], u2[8], bb[8];
        {
          const u32x4 x = *(const u32x4*)(row + c), cc = *(const u32x4*)(row + 512 + c), bv = *(const u32x4*)(row + 256 + c);
#pragma unroll
          for (int j = 0; j < 4; ++j) {
            u1[2 * j] = __uint_as_float(x[j] << 16) * __uint_as_float(cc[j] << 16); u1[2 * j + 1] = __uint_as_float(x[j] & 0xffff0000u) * __uint_as_float(cc[j] & 0xffff0000u);
            bb[2 * j] = __uint_as_float(bv[j] << 16); bb[2 * j + 1] = __uint_as_float(bv[j] & 0xffff0000u);
          }
        }
        if (s > 0) {
          const u32x4 x = *(const u32x4*)(row - 768 + c), cc = *(const u32x4*)(row - 768 + 512 + c);
#pragma unroll
          for (int j = 0; j < 4; ++j) { u0[2 * j] = __uint_as_float(x[j] << 16) * __uint_as_float(cc[j] << 16); u0[2 * j + 1] = __uint_as_float(x[j] & 0xffff0000u) * __uint_as_float(cc[j] & 0xffff0000u); }
        } else {
#pragma unroll
          for (int j = 0; j < 8; ++j) u0[j] = 0.f;
        }
        if (s < slen - 1) {
          const u32x4 x = *(const u32x4*)(row + 768 + c), cc = *(const u32x4*)(row + 768 + 512 + c);
#pragma unroll
          for (int j = 0; j < 4; ++j) { u2[2 * j] = __uint_as_float(x[j] << 16) * __uint_as_float(cc[j] << 16); u2[2 * j + 1] = __uint_as_float(x[j] & 0xffff0000u) * __uint_as_float(cc[j] & 0xffff0000u); }
        } else {
#pragma unroll
          for (int j = 0; j < 8; ++j) u2[j] = 0.f;
        }
        float o[8];
#pragma unroll
        for (int q = 0; q < 2; ++q) {
          const f32x4 w0 = *(const f32x4*)(cw + c + 4 * q), w1 = *(const f32x4*)(cw + 256 + c + 4 * q), w2 = *(const f32x4*)(cw + 512 + c + 4 * q);
#pragma unroll
          for (int j = 0; j < 4; ++j) o[4 * q + j] = bb[4 * q + j] * (u0[4 * q + j] * w0[j] + u1[4 * q + j] * w1[j] + u2[4 * q + j] * w2[j]);
        }
        u32x4 ov = {pack2(o[0], o[1]), pack2(o[2], o[3]), pack2(o[4], o[5]), pack2(o[6], o[7])};
        *(u32x4*)(Y + (size_t)T * 1024 + c) = ov;
      }
    }
    GSYNC();
    }
    for (int rep = 0; rep < REP_P3; ++rep) {
      const float lam_init = l == 0 ? 0.2f : 0.8f - 0.6f * 0.7408182206817179f;
      float d1 = 0.f, d2 = 0.f;
      for (int j = 0; j < 32; ++j) { d1 += p.lq1[l * 32 + j] * p.lk1[l * 32 + j]; d2 += p.lq2[l * 32 + j] * p.lk2[l * 32 + j]; }
      const float lam = expf(d1) - expf(d2) + lam_init;
      const float* nw = p.diff_norm_w + l * 64;
      for (;;) {
        __syncthreads();
        if (tid == 0) s_unit = atomicAdd(CTR + 16 + (l + 2 * rep) * 8 + (bid & 7), 1);
        __syncthreads();
        const int vq = __builtin_amdgcn_readfirstlane(s_unit);
        if (vq >= 112) break;
        int u;
        {
          const int x = bid & 7;
          if (vq < 32) u = (2 * x + (vq >> 4)) * 16 + (vq & 15);
          else if (vq < 64) { const int v1 = vq - 32; u = 256 + (x * 16 + (v1 & 15)) * 2 + (v1 >> 4); }
          else if (vq < 96) { const int v1 = vq - 64; u = 512 + (16 * x + (v1 >> 1)) * 2 + (v1 & 1); }
          else { const int v1 = vq - 96; u = 768 + (8 * x + (v1 >> 1)) * 2 + (v1 & 1); }
        }
        const bf16_t *Qp, *Kp, *VTp; bf16_t* Yp; int S_all, mode, mapidx = 0, pairid = 0;
        if (u < 256) {
          const int b = u >> 7, hh = (u >> 4) & 7, qb = u & 15; mode = 0; S_all = 2560;
          Qp = QM + (size_t)NPR * 768 + (((size_t)b * 8 + hh) * 2048 + qb * 128) * 96; Kp = KMSl + ((size_t)b * 8 + hh) * 2560 * 96; VTp = VMTSl + ((size_t)b * 8 + hh) * 64 * 2560;
          Yp = Y + (size_t)(NPR + b * 2048 + qb * 128) * 1024 + 512 + hh * 64;
        } else if (u < 512) {
          const int v2 = u - 256; pairid = v2 >> 1; mapidx = v2 & 1;
          const int b = pairid >> 6, hd = (pairid >> 4) & 3, qb = pairid & 15; mode = 2; S_all = 2560;
          Qp = DQ + (size_t)NPR * 256 + ((((size_t)b * 4 + hd) * 2 + mapidx) * 2048 + qb * 128) * 32; Kp = DKSl + (((size_t)b * 4 + hd) * 2 + mapidx) * 2560 * 32; VTp = DVTSl + ((size_t)b * 4 + hd) * 64 * 2560;
          Yp = Y + (size_t)(NPR + b * 2048 + qb * 128) * 1024 + 256 + hd * 64;
        } else if (u < 768) {
          const int v = u - 512, b = v >> 4, hh = (v >> 1) & 7, qb = v & 1; mode = 0; S_all = 256;
          Qp = QM + (((size_t)b * 8 + hh) * 256 + qb * 128) * 96; Kp = KMP + ((size_t)b * 8 + hh) * 256 * 96; VTp = VMTP + ((size_t)b * 8 + hh) * 64 * 256;
          Yp = Y + (size_t)(b * 256 + qb * 128) * 1024 + 512 + hh * 64;
        } else {
          const int v = u - 768, b = v >> 3, hd = (v >> 1) & 3, qb = v & 1; mode = 1; S_all = 256;
          Qp = DQ + ((((size_t)b * 4 + hd) * 2) * 256 + qb * 128) * 32; Kp = DKP + (((size_t)b * 4 + hd) * 2) * 256 * 32; VTp = DVTP + ((size_t)b * 4 + hd) * 64 * 256;
          Yp = Y + (size_t)(b * 256 + qb * 128) * 1024 + 256 + hd * 64;
        }
        float* owsp = (float*)(ws + O_OWS) + ((size_t)(l * 128 + pairid) * 2) * 128 * 64;
        unsigned* flg = (unsigned*)(ws + O_FLG) + l * 128 + pairid + 256 * rep;
        if (mode == 1) attn_unit<1>(Qp, (size_t)256 * 32, Kp, (size_t)256 * 32, VTp, S_all, S_all, Yp, lam, nw, 1.f - lam_init, smem, nullptr, nullptr, 0, &s_flag);
        else if (mode == 2) attn_unit<2>(Qp, 0, Kp, 0, VTp, S_all, S_all, Yp, lam, nw, 1.f - lam_init, smem, owsp, flg, mapidx, &s_flag);
        else attn_unit<0>(Qp, 0, Kp, 0, VTp, S_all, S_all, Yp, 0.f, nw, 1.f, smem, nullptr, nullptr, 0, &s_flag);
      }
      GSYNC();
    }
    {
      EpiResLN e{l == 0 ? p.x_prompt : XZ, l == 0 ? p.x_sample : XZ + (size_t)NPR * 1024, XZ, H, MODl + 2 * 1024, p.ln1_g + l * 1024, p.ln1_b + l * 1024, MODl + 3 * 1024,
                 (unsigned long long*)(ws + O_EXCH) + (size_t)(l * 2 + 0) * 64 * 8 * 128, (unsigned*)(ws + O_LNC) + (size_t)(l * 2 + 0) * 64 * 64, smem, 0, 0};
      const bf16_t* Bt = WOUT + (size_t)l * 1024 * 1024;
      for (int j = bid >> 3; j < 8 * 8; j += G >> 3) { e.mt = (bid & 7) * 8 + (j >> 3); e.nt = j & 7; gemm_tile(Y, 1024, Bt, 1024, 1024, e.mt * 128, e.nt * 128, smem, e); }
    }
    GSYNC();
#ifdef PROBE_BD
    {
      EpiFfUp e{ACT};
      const bf16_t* Bt = W13 + (size_t)l * 5632 * 1024;
      for (int j = bid >> 3; j < 8 * 44; j += G >> 3) gemm_tile_bd(H, 1024, Bt, 1024, ((bid & 7) * 8 + (j & 7)) * 128, (j >> 3) * 128, smem, e);
      GSYNC();
    }
#endif
    for (int rep = 0; rep < REP_P6; ++rep) {
      EpiFfUp e{ACT};
      const bf16_t* Bt = W13 + (size_t)l * 5632 * 1024;
      gemm_phase(H, 1024, Bt, 1024, 1024, (bid & 7) * 8, bid >> 3, 8 * 44, G >> 3, smem, e);
      GSYNC();
    }
    {
      EpiResLN e{XZ, XZ + (size_t)NPR * 1024, l == 0 ? XZ : p.out + OUT_Y, l == 0 ? H : nullptr, MODl + 5 * 1024, p.ln2_g + l * 1024, p.ln2_b + l * 1024, MOD + (size_t)3 * 6144,
                 (unsigned long long*)(ws + O_EXCH) + (size_t)(l * 2 + 1) * 64 * 8 * 128, (unsigned*)(ws + O_LNC) + (size_t)(l * 2 + 1) * 64 * 64, smem, 0, 0};
      const bf16_t* Bt = W2 + (size_t)l * 1024 * DFF;
      for (int j = bid >> 3; j < 8 * 8; j += G >> 3) { e.mt = (bid & 7) * 8 + (j >> 3); e.nt = j & 7; gemm_tile(ACT, DFF, Bt, DFF, DFF, e.mt * 128, e.nt * 128, smem, e); }
    }
    if (l == 0) GSYNC();
  }
}

extern "C" void kernel_launch(void* const* d_in, const int* in_sizes, int n_in, void* d_out, int out_size, void* d_ws, size_t ws_size, hipStream_t stream) {
  static int grid_blocks = 0;
  if (!grid_blocks) {
    int dev = 0, cus = 0, per_cu = 0;
    hipGetDevice(&dev);
    hipDeviceGetAttribute(&cus, hipDeviceAttributeMultiprocessorCount, dev);
    hipOccupancyMaxActiveBlocksPerMultiprocessor(&per_cu, mega, 256, 0);
    if (per_cu > 2) per_cu = 2;
    if (per_cu < 1) per_cu = 1;
    grid_blocks = (cus * per_cu) & ~7;
  }
  if (ws_size < WS_NEED) { fprintf(stderr, "workspace too small: %zu < %zu\n", ws_size, (size_t)WS_NEED); return; }
  Params p{};
  const float** pp = (const float**)&p;
  for (int i = 0; i < 29; ++i) pp[i] = (const float*)d_in[i];
  p.out = (float*)d_out; p.ws = (char*)d_ws;
  hipMemsetAsync((char*)d_ws + O_CTR, 0, O_OVL - O_CTR, stream);
  void* args[] = {&p};
  hipError_t e = hipLaunchCooperativeKernel((void*)mega, dim3(grid_blocks), dim3(256), args, 0, stream);
  if (e != hipSuccess) fprintf(stderr, "cooperative launch failed: %s (grid %d)\n", hipGetErrorString(e), grid_blocks);
}
```

```cpp
#include <hip/hip_runtime.h>
#include <hip/hip_cooperative_groups.h>
#include <cstdio>
#include <cstdint>
namespace cg = cooperative_groups;

typedef unsigned short bf16_t;
typedef short bf16x8 __attribute__((ext_vector_type(8)));
typedef short s16x4 __attribute__((ext_vector_type(4)));
typedef float f32x16 __attribute__((ext_vector_type(16)));
typedef float f32x4 __attribute__((ext_vector_type(4)));
typedef float f32x2 __attribute__((ext_vector_type(2)));
typedef unsigned u32x4 __attribute__((ext_vector_type(4)));
typedef unsigned u32x2 __attribute__((ext_vector_type(2)));
typedef __bf16 bf2_t __attribute__((ext_vector_type(2)));

#ifndef REP_P0
#define REP_P0 1
#endif
#ifndef REP_P1
#define REP_P1 1
#endif
#ifndef REP_P2
#define REP_P2 1
#endif
#ifndef REP_P3
#define REP_P3 1
#endif
#ifndef REP_P6
#define REP_P6 1
#endif
#ifndef REP_SYNC
#define REP_SYNC 0
#endif
#define DI __device__ __forceinline__
#define MFMA(a, b, c) __builtin_amdgcn_mfma_f32_32x32x16_bf16((a), (b), (c), 0, 0, 0)

constexpr int NTOK = 8192, NPR = 4096, DM = 1024, INC = 2208, INP = 2304, DFF = 2816;
constexpr float LOG2E = 1.4426950408889634f;
constexpr float ALPHA = 1.4142135623730951f;
constexpr float QSC_DIFF = 0.17677669529663687f * LOG2E;
constexpr float QSC_MLA = 0.10206207261596575f * LOG2E;

constexpr size_t al(size_t x) { return (x + 255) & ~(size_t)255; }
constexpr size_t O_WIN = 0;
constexpr size_t O_WUQ = O_WIN + al(2ull * INP * 1024 * 2);
constexpr size_t O_WUKVN = O_WUQ + al(2ull * 768 * 384 * 2);
constexpr size_t O_WUKVC = O_WUKVN + al(2ull * 1024 * 256 * 2);
constexpr size_t O_WOUT = O_WUKVC + al(2ull * 1024 * 256 * 2);
constexpr size_t O_W13 = O_WOUT + al(2ull * 1024 * 1024 * 2);
constexpr size_t O_W2 = O_W13 + al(2ull * 5632 * 1024 * 2);
constexpr size_t O_H = O_W2 + al(2ull * 1024 * 2816 * 2);
constexpr size_t O_DKP = O_H + al(8192ull * 1024 * 2);
constexpr size_t N_DKS = 2ull * 4 * 2 * 2560 * 32;
constexpr size_t O_DKS = O_DKP + al(16ull * 4 * 2 * 256 * 32 * 2);
constexpr size_t O_DVTP = O_DKS + al(2 * N_DKS * 2);
constexpr size_t N_DVTS = 2ull * 4 * 64 * 2560;
constexpr size_t O_DVTS = O_DVTP + al(16ull * 4 * 64 * 256 * 2);
constexpr size_t O_KMP = O_DVTS + al(2 * N_DVTS * 2);
constexpr size_t N_KMS = 2ull * 8 * 2560 * 96;
constexpr size_t O_KMS = O_KMP + al(16ull * 8 * 256 * 96 * 2);
constexpr size_t O_VMTP = O_KMS + al(2 * N_KMS * 2);
constexpr size_t N_VMTS = 2ull * 8 * 64 * 2560;
constexpr size_t O_VMTS = O_VMTP + al(16ull * 8 * 64 * 256 * 2);
constexpr size_t O_CKVC = O_VMTS + al(2 * N_VMTS * 2);
constexpr size_t O_CKVF = O_CKVC + al(2ull * 2 * 512 * 256 * 2);
constexpr size_t O_XZ = O_CKVF + al(4096ull * 256 * 4);
constexpr size_t O_EXCH = O_XZ + al(8192ull * 1024 * 4);
constexpr size_t O_OWS = O_EXCH + al(4ull * 64 * 8 * 128 * 8);
constexpr size_t O_PART = O_OWS + al(2ull * 128 * 2 * 128 * 64 * 4);
constexpr size_t O_CTR = O_PART + al(2ull * 64 * 3 * 6144 * 4);
constexpr size_t O_BAR = O_CTR + 256;
constexpr size_t O_SSQ = O_BAR + al(3456 * 4);
constexpr size_t O_FLG = O_SSQ + al(2ull * 2 * 8192 * 4);
constexpr size_t O_MOD = O_FLG + al(4ull * 128 * 4);
constexpr size_t O_LNC = O_MOD + al(2ull * 3 * 6144 * 4);
constexpr size_t O_OVL = O_LNC + al(4ull * 64 * 64 * 4);
constexpr size_t O_AX = O_OVL;
constexpr size_t O_DQ = O_AX + al(8192ull * 768 * 2);
constexpr size_t O_CQ = O_DQ + al(8192ull * 256 * 2);
constexpr size_t O_CKVB = O_CQ + al(8192ull * 384 * 2);
constexpr size_t O_QM = O_CKVB + al(8192ull * 256 * 2);
constexpr size_t O_Y = O_QM + al(8192ull * 768 * 2);
constexpr size_t O_END1 = O_Y + al(8192ull * 1024 * 2);
constexpr size_t O_ACT = O_OVL;
constexpr size_t O_END2 = O_ACT + al(8192ull * 2816 * 2);
constexpr size_t WS_NEED = O_END1 > O_END2 ? O_END1 : O_END2;
static_assert(WS_NEED <= (256ull << 20), "workspace too large");

constexpr size_t OUT_Y = 0;
constexpr size_t OUT_SK = 8388608;
constexpr size_t OUT_SV = 10485760;
constexpr size_t OUT_CKV = 12582912;
constexpr size_t OUT_KPE = 14680064;

constexpr int SMEM_BYTES = 65536 + 4096;

struct Params {
  const float* x_prompt; const float* x_sample; const float* cache_k; const float* cache_v; const float* cache_ckv; const float* cache_kpe;
  const float* c; const float* c_ctx; const float* w_ada; const float* b_ada; const float* w_in; const float* conv_w;
  const float* lq1; const float* lk1; const float* lq2; const float* lk2; const float* diff_norm_w; const float* q_norm_w; const float* w_uq;
  const float* kv_norm_w; const float* w_ukv; const float* w_out; const float* ln1_g; const float* ln1_b; const float* w_ff1; const float* w_ff3;
  const float* w_ff2; const float* ln2_g; const float* ln2_b;
  float* out; char* ws;
};

DI int my_tid() { int t = threadIdx.x; asm volatile("" : "+v"(t)); return t; }
DI unsigned pack2(float lo, float hi) {
  f32x2 v = {lo, hi};
  bf2_t b = __builtin_convertvector(v, bf2_t);
  return __builtin_bit_cast(unsigned, b);
}
DI bf16_t f2bf(float x) { return (bf16_t)(pack2(x, 0.f) & 0xffffu); }
DI void st4bf(bf16_t* p, float a, float b, float c, float d) { u32x2 v = {pack2(a, b), pack2(c, d)}; *(u32x2*)p = v; }
DI void st_tile32_bf16(bf16_t* p0, int h, float v0, float v1, float v2, float v3, float v4, float v5, float v6, float v7,
                       float v8, float v9, float v10, float v11, float v12, float v13, float v14, float v15) {
  unsigned a0 = pack2(v0, v1), a1 = pack2(v2, v3), b0 = pack2(v4, v5), b1 = pack2(v6, v7);
  unsigned c0 = pack2(v8, v9), c1 = pack2(v10, v11), d0 = pack2(v12, v13), d1 = pack2(v14, v15);
  { auto r0 = __builtin_amdgcn_permlane32_swap(a0, b0, false, false); auto r1 = __builtin_amdgcn_permlane32_swap(a1, b1, false, false);
    u32x4 o = {r0[0], r1[0], r0[1], r1[1]}; *(u32x4*)(p0 + 8 * h) = o; }
  { auto r0 = __builtin_amdgcn_permlane32_swap(c0, d0, false, false); auto r1 = __builtin_amdgcn_permlane32_swap(c1, d1, false, false);
    u32x4 o = {r0[0], r1[0], r0[1], r1[1]}; *(u32x4*)(p0 + 16 + 8 * h) = o; }
}
#define ST_TILE32(P0, H, V, SC) st_tile32_bf16((P0), (H), (V)[0] * (SC), (V)[1] * (SC), (V)[2] * (SC), (V)[3] * (SC), (V)[4] * (SC), (V)[5] * (SC), (V)[6] * (SC), (V)[7] * (SC), \
    (V)[8] * (SC), (V)[9] * (SC), (V)[10] * (SC), (V)[11] * (SC), (V)[12] * (SC), (V)[13] * (SC), (V)[14] * (SC), (V)[15] * (SC))
DI float xor32_max(float x) { auto r = __builtin_amdgcn_permlane32_swap(__float_as_uint(x), __float_as_uint(x), false, false); return fmaxf(__uint_as_float(r[0]), __uint_as_float(r[1])); }
DI float xor32_sum(float x) { auto r = __builtin_amdgcn_permlane32_swap(__float_as_uint(x), __float_as_uint(x), false, false); return __uint_as_float(r[0]) + __uint_as_float(r[1]); }
DI float bf2f(bf16_t x) { return __uint_as_float(((unsigned)x) << 16); }

DI void rope16(f32x16& v, int s, int h) {
  const float pr = (float)(s >> 6), pc = (float)(s & 63);
#pragma unroll
  for (int i = 0; i < 4; ++i) {
    const float f = __builtin_amdgcn_exp2f(-1.6609640474436813f * (float)(4 * h + i));
    const float a1 = pr * f, a2 = pc * f;
    const float c1 = __cosf(a1), s1 = __sinf(a1), c2 = __cosf(a2), s2 = __sinf(a2);
    const float x1 = v[i], x2 = v[4 + i];
    v[i] = x1 * c1 - x2 * s1; v[4 + i] = x1 * s1 + x2 * c1;
    const float y1 = v[8 + i], y2 = v[12 + i];
    v[8 + i] = y1 * c2 - y2 * s2; v[12 + i] = y1 * s2 + y2 * c2;
  }
}

template <int SWAPMODE = 0, class Epi>
DI void gemm_tile(const bf16_t* __restrict__ A, int lda, const bf16_t* __restrict__ Bt, int ldb, int K, int m0, int n0, char* smem, const Epi& epi) {
  const int tid = my_tid(), lane = tid & 63, w = tid >> 6, wm = w & 1, wn = w >> 1, r = lane & 31, h = lane >> 5;
  constexpr bool swp = SWAPMODE == 1;
  f32x16 acc[2][2];
#pragma unroll
  for (int a = 0; a < 2; ++a)
#pragma unroll
    for (int b = 0; b < 2; ++b)
#pragma unroll
      for (int i = 0; i < 16; ++i) acc[a][b][i] = 0.f;
  const int srow = tid >> 3, sch = tid & 7;
  const bf16_t* ga = A + (size_t)(m0 + srow) * lda + sch * 8;
  const bf16_t* gb = Bt + (size_t)(n0 + srow) * ldb + sch * 8;
  const int swoff = srow * 128 + ((sch ^ ((srow >> 1) & 7)) << 4);
  u32x4 ra0[4], rb0[4], ra1[4], rb1[4];
  const int nk = K >> 6;
  const int sw = (r >> 1) & 7;
  const int arow = (wm * 64 + r) * 128, brow = 16384 + (wn * 64 + r) * 128;
#define G_LOAD(RA, RB, KT) do { _Pragma("unroll") for (int i = 0; i < 4; ++i) { RA[i] = *(const u32x4*)(ga + (size_t)(32 * i) * lda + (KT) * 64); RB[i] = *(const u32x4*)(gb + (size_t)(32 * i) * ldb + (KT) * 64); } } while (0)
#define S_WRITE(RA, RB, ST) do { _Pragma("unroll") for (int i = 0; i < 4; ++i) { *(u32x4*)(smem + (ST) * 32768 + swoff + i * 4096) = RA[i]; *(u32x4*)(smem + (ST) * 32768 + 16384 + swoff + i * 4096) = RB[i]; } } while (0)
#define G_FRAGS(ST, KK, FA, FB) do { const int co_ = (((KK) * 2 + h) ^ sw) << 4; \
    _Pragma("unroll") for (int mi = 0; mi < 2; ++mi) FA[mi] = *(const bf16x8*)(smem + (ST) * 32768 + arow + mi * 4096 + co_); \
    _Pragma("unroll") for (int ni = 0; ni < 2; ++ni) FB[ni] = *(const bf16x8*)(smem + (ST) * 32768 + brow + ni * 4096 + co_); } while (0)
#define G_MMA(FA, FB) do { if (SWAPMODE != 0 && swp) { _Pragma("unroll") for (int mi = 0; mi < 2; ++mi) _Pragma("unroll") for (int ni = 0; ni < 2; ++ni) acc[mi][ni] = MFMA(FA[mi], FB[ni], acc[mi][ni]); } \
    else { _Pragma("unroll") for (int mi = 0; mi < 2; ++mi) _Pragma("unroll") for (int ni = 0; ni < 2; ++ni) acc[mi][ni] = MFMA(FB[ni], FA[mi], acc[mi][ni]); } } while (0)
#define G_COMPUTE(ST) do { bf16x8 fa0[2], fb0[2], fa1[2], fb1[2]; \
    G_FRAGS(ST, 0, fa0, fb0); \
    G_FRAGS(ST, 1, fa1, fb1); __builtin_amdgcn_sched_barrier(0); \
    G_MMA(fa0, fb0); __builtin_amdgcn_sched_barrier(0); \
    G_FRAGS(ST, 2, fa0, fb0); __builtin_amdgcn_sched_barrier(0); \
    G_MMA(fa1, fb1); __builtin_amdgcn_sched_barrier(0); \
    G_FRAGS(ST, 3, fa1, fb1); __builtin_amdgcn_sched_barrier(0); \
    G_MMA(fa0, fb0); __builtin_amdgcn_sched_barrier(0); \
    G_MMA(fa1, fb1); } while (0)
  G_LOAD(ra0, rb0, 0);
  G_LOAD(ra1, rb1, 1);
  S_WRITE(ra0, rb0, 0);
  __syncthreads();
  for (int kt = 0; kt < nk; kt += 2) {
    G_LOAD(ra0, rb0, (kt + 2 < nk ? kt + 2 : nk - 1));
    G_COMPUTE(0);
    S_WRITE(ra1, rb1, 1);
    __syncthreads();
    G_LOAD(ra1, rb1, (kt + 3 < nk ? kt + 3 : nk - 1));
    G_COMPUTE(1);
    S_WRITE(ra0, rb0, 0);
    __syncthreads();
  }
#undef G_LOAD
#undef S_WRITE
#undef G_COMPUTE
#undef G_FRAGS
#undef G_MMA
  epi(acc, m0 + wm * 64, n0 + wn * 64, r, h);
}


template <class Epi>
DI void gemm_phase(const bf16_t* __restrict__ A, int lda, const bf16_t* __restrict__ Bt, int ldb, int K, int x8, int j0, int jend, int jstep, char* smem, const Epi& epi) {
  if (j0 >= jend) return;
  const int tid = my_tid(), lane = tid & 63, w = tid >> 6, wm = w & 1, wn = w >> 1, r = lane & 31, h = lane >> 5;
  const int srow = tid >> 3, sch = tid & 7;
  const int swoff = srow * 128 + ((sch ^ ((srow >> 1) & 7)) << 4);
  u32x4 ra0[4], rb0[4], ra1[4], rb1[4];
  const int nk = K >> 6;
  const int sw = (r >> 1) & 7;
  const int arow = (wm * 64 + r) * 128, brow = 16384 + (wn * 64 + r) * 128;
#define P_LOAD(RA, RB, PA, PB) do { _Pragma("unroll") for (int i = 0; i < 4; ++i) { RA[i] = *(const u32x4*)((PA) + (size_t)(32 * i) * lda); RB[i] = *(const u32x4*)((PB) + (size_t)(32 * i) * ldb); } } while (0)
#define S_WRITE(RA, RB, ST) do { _Pragma("unroll") for (int i = 0; i < 4; ++i) { *(u32x4*)(smem + (ST) * 32768 + swoff + i * 4096) = RA[i]; *(u32x4*)(smem + (ST) * 32768 + 16384 + swoff + i * 4096) = RB[i]; } } while (0)
#define G_FRAGS(ST, KK, FA, FB) do { const int co_ = (((KK) * 2 + h) ^ sw) << 4; \
    _Pragma("unroll") for (int mi = 0; mi < 2; ++mi) FA[mi] = *(const bf16x8*)(smem + (ST) * 32768 + arow + mi * 4096 + co_); \
    _Pragma("unroll") for (int ni = 0; ni < 2; ++ni) FB[ni] = *(const bf16x8*)(smem + (ST) * 32768 + brow + ni * 4096 + co_); } while (0)
#define G_MMA(FA, FB) do { _Pragma("unroll") for (int mi = 0; mi < 2; ++mi) _Pragma("unroll") for (int ni = 0; ni < 2; ++ni) acc[mi][ni] = MFMA(FB[ni], FA[mi], acc[mi][ni]); } while (0)
#define G_COMPUTE(ST) do { bf16x8 fa0[2], fb0[2], fa1[2], fb1[2]; \
    G_FRAGS(ST, 0, fa0, fb0); \
    G_FRAGS(ST, 1, fa1, fb1); __builtin_amdgcn_sched_barrier(0); \
    G_MMA(fa0, fb0); __builtin_amdgcn_sched_barrier(0); \
    G_FRAGS(ST, 2, fa0, fb0); __builtin_amdgcn_sched_barrier(0); \
    G_MMA(fa1, fb1); __builtin_amdgcn_sched_barrier(0); \
    G_FRAGS(ST, 3, fa1, fb1); __builtin_amdgcn_sched_barrier(0); \
    G_MMA(fa0, fb0); __builtin_amdgcn_sched_barrier(0); \
    G_MMA(fa1, fb1); } while (0)
  int j = j0;
  int m0 = (x8 + (j & 7)) * 128, n0 = (j >> 3) * 128;
  const bf16_t* ga = A + (size_t)(m0 + srow) * lda + sch * 8;
  const bf16_t* gb = Bt + (size_t)(n0 + srow) * ldb + sch * 8;
  P_LOAD(ra0, rb0, ga, gb);
  P_LOAD(ra1, rb1, ga + 64, gb + 64);
  S_WRITE(ra0, rb0, 0);
  __syncthreads();
  for (;;) {
    const int jn = j + jstep;
    const bool has_next = jn < jend;
    const int m1 = has_next ? (x8 + (jn & 7)) * 128 : m0, n1 = has_next ? (jn >> 3) * 128 : n0;
    const bf16_t* gan = A + (size_t)(m1 + srow) * lda + sch * 8;
    const bf16_t* gbn = Bt + (size_t)(n1 + srow) * ldb + sch * 8;
    f32x16 acc[2][2];
#pragma unroll
    for (int a = 0; a < 2; ++a)
#pragma unroll
      for (int b = 0; b < 2; ++b)
#pragma unroll
        for (int i = 0; i < 16; ++i) acc[a][b][i] = 0.f;
    for (int kt = 0; kt < nk; kt += 2) {
      const bool last = kt + 2 >= nk;
      const bf16_t* pa = last ? gan : ga + (kt + 2) * 64; const bf16_t* pb = last ? gbn : gb + (kt + 2) * 64;
      P_LOAD(ra0, rb0, pa, pb);
      G_COMPUTE(0);
      S_WRITE(ra1, rb1, 1);
      __syncthreads();
      P_LOAD(ra1, rb1, pa + 64, pb + 64);
      G_COMPUTE(1);
      S_WRITE(ra0, rb0, 0);
      __syncthreads();
    }
    epi(acc, m0 + wm * 64, n0 + wn * 64, r, h);
    if (!has_next) break;
    j = jn; m0 = m1; n0 = n1; ga = gan; gb = gbn;
  }
#undef P_LOAD
#undef S_WRITE
#undef G_COMPUTE
#undef G_FRAGS
#undef G_MMA
}

template <class Epi>
DI void gemm_tile_bd(const bf16_t* __restrict__ A, int lda, const bf16_t* __restrict__ Bf, int K, int m0, int n0, char* smem, const Epi& epi) {
  const int tid = my_tid(), lane = tid & 63, w = tid >> 6, wm = w & 1, wn = w >> 1, r = lane & 31, h = lane >> 5;
  f32x16 acc[2][2];
#pragma unroll
  for (int a = 0; a < 2; ++a)
#pragma unroll
    for (int b = 0; b < 2; ++b)
#pragma unroll
      for (int i = 0; i < 16; ++i) acc[a][b][i] = 0.f;
  const int srow = tid >> 3, sch = tid & 7;
  const bf16_t* ga = A + (size_t)(m0 + srow) * lda + sch * 8;
  const int swoff = srow * 128 + ((sch ^ ((srow >> 1) & 7)) << 4);
  const int k16 = K >> 4;
  const bf16_t* gb0 = Bf + ((size_t)(((n0 + wn * 64) >> 5) + 0) * k16 * 64 + lane) * 8;
  const bf16_t* gb1 = Bf + ((size_t)(((n0 + wn * 64) >> 5) + 1) * k16 * 64 + lane) * 8;
  u32x4 ra0[4], ra1[4];
  bf16x8 bq0[2][4], bq1[2][4];
  const int nk = K >> 6;
  const int sw = (r >> 1) & 7;
  const int arow = (wm * 64 + r) * 128;
#define GA_LOAD(RA, KT) do { _Pragma("unroll") for (int i = 0; i < 4; ++i) RA[i] = *(const u32x4*)(ga + (size_t)(32 * i) * lda + (KT) * 64); } while (0)
#define GB_LOAD(BQ, KT) do { _Pragma("unroll") for (int kk = 0; kk < 4; ++kk) { BQ[0][kk] = *(const bf16x8*)(gb0 + (size_t)((KT) * 4 + kk) * 512); BQ[1][kk] = *(const bf16x8*)(gb1 + (size_t)((KT) * 4 + kk) * 512); } } while (0)
#define SA_WRITE(RA, ST) do { _Pragma("unroll") for (int i = 0; i < 4; ++i) *(u32x4*)(smem + (ST) * 16384 + swoff + i * 4096) = RA[i]; } while (0)
#define GBD_COMPUTE(ST, BQ) do { _Pragma("unroll") for (int kk = 0; kk < 4; ++kk) { const int co = ((kk * 2 + h) ^ sw) << 4; bf16x8 fa[2]; \
    _Pragma("unroll") for (int mi = 0; mi < 2; ++mi) fa[mi] = *(const bf16x8*)(smem + (ST) * 16384 + arow + mi * 4096 + co); \
    _Pragma("unroll") for (int mi = 0; mi < 2; ++mi) _Pragma("unroll") for (int ni = 0; ni < 2; ++ni) acc[mi][ni] = MFMA(BQ[ni][kk], fa[mi], acc[mi][ni]); } } while (0)
  GA_LOAD(ra0, 0);
  GA_LOAD(ra1, 1);
  GB_LOAD(bq0, 0);
  SA_WRITE(ra0, 0);
  __syncthreads();
  for (int kt = 0; kt < nk; kt += 2) {
    GB_LOAD(bq1, kt + 1);
    if (kt + 2 < nk) GA_LOAD(ra0, kt + 2);
    GBD_COMPUTE(0, bq0);
    SA_WRITE(ra1, 1);
    __syncthreads();
    if (kt + 2 < nk) GB_LOAD(bq0, kt + 2);
    if (kt + 3 < nk) GA_LOAD(ra1, kt + 3);
    GBD_COMPUTE(1, bq1);
    if (kt + 2 < nk) SA_WRITE(ra0, 0);
    __syncthreads();
  }
#undef GA_LOAD
#undef GB_LOAD
#undef SA_WRITE
#undef GBD_COMPUTE
  epi(acc, m0 + wm * 64, n0 + wn * 64, r, h);
}

DI void row_rms(const bf16_t* __restrict__ A, int lda, int K, int m0, float* rs) {
  const int tid = my_tid(), row = tid >> 1, half = tid & 1;
  const bf16_t* p = A + (size_t)(m0 + row) * lda + half * (K >> 1);
  float s = 0.f;
  for (int k = 0; k < (K >> 1); k += 8) {
    u32x4 v = *(const u32x4*)(p + k);
#pragma unroll
    for (int j = 0; j < 4; ++j) { float a = __uint_as_float(v[j] << 16), b = __uint_as_float(v[j] & 0xffff0000u); s += a * a + b * b; }
  }
  s += __shfl_xor(s, 1);
  if (half == 0) rs[row] = rsqrtf(s / (float)K + 1e-6f);
}

DI void tok_decode(int T, bool& smp, int& b, int& s) {
  smp = T >= NPR;
  if (!smp) { b = T >> 8; s = T & 255; } else { const int t2 = T - NPR; b = t2 >> 11; s = t2 & 2047; }
}

template <int MASK> struct EpiInT {
  int l; bf16_t *AX, *DQ, *DKP, *DKS, *DVTP, *DVTS, *CQ, *CKVB, *KMP, *KMS; float* CKVF; float* out; float* SSQ;
  DI void operator()(f32x16 (&acc)[2][2], int tb, int nb, int r, int h) const {
#pragma unroll
    for (int mi = 0; mi < 2; ++mi) {
      const int T = tb + mi * 32 + r; bool smp; int b, s; tok_decode(T, smp, b, s);
#pragma unroll
      for (int ni = 0; ni < 2; ++ni) {
        const int nt = nb + ni * 32; f32x16 v = acc[mi][ni];
        if (nt < 768) { if (MASK & 1) {
          ST_TILE32(AX + (size_t)T * 768 + nt, h, v, 1.f);
        } } else if (nt < 1024) { if (MASK & 2) {
          const int c = nt - 768, hd = c >> 6, mp = (c >> 5) & 1;
          if (smp) rope16(v, s, h);
          const size_t base = smp ? (size_t)NPR * 256 + ((((size_t)b * 4 + hd) * 2 + mp) * 2048 + s) * 32 : ((((size_t)b * 4 + hd) * 2 + mp) * 256 + s) * 32;
          ST_TILE32(DQ + base, h, v, QSC_DIFF);
        } } else if (nt < 1280) { if (MASK & 2) {
          const int c = nt - 1024, hd = c >> 6, mp = (c >> 5) & 1;
          if (!smp) {
            float* o = out + OUT_SK + ((((((size_t)b * 2 + l) * 4 + hd) * 2 + mp) * 256 + s) * 32) + 4 * h;
            bf16_t* d = DKP + ((((size_t)b * 4 + hd) * 2 + mp) * 256 + s) * 32 + 4 * h;
#pragma unroll
            for (int g = 0; g < 4; ++g) { f32x4 t = {v[4 * g], v[4 * g + 1], v[4 * g + 2], v[4 * g + 3]}; *(f32x4*)(o + 8 * g) = t; }
            ST_TILE32(d - 4 * h, h, v, 1.f);
          } else {
            rope16(v, s, h);
            ST_TILE32(DKS + ((((size_t)b * 4 + hd) * 2 + mp) * 2560 + s) * 32, h, v, 1.f);
          }
        } } else if (nt < 1536) { if (MASK & 4) {
          const int c = nt - 1280, hd = c >> 6, dvb = c & 63;
          if (!smp) {
            float* o = out + OUT_SV + (((((size_t)b * 2 + l) * 4 + hd) * 256 + s) * 64) + dvb + 4 * h;
            bf16_t* d = DVTP + (((size_t)b * 4 + hd) * 64 + dvb + 4 * h) * 256 + s;
#pragma unroll
            for (int g = 0; g < 4; ++g) {
              f32x4 t = {v[4 * g], v[4 * g + 1], v[4 * g + 2], v[4 * g + 3]}; *(f32x4*)(o + 8 * g) = t;
#pragma unroll
              for (int j = 0; j < 4; ++j) d[(size_t)(8 * g + j) * 256] = f2bf(t[j]);
            }
          } else {
            bf16_t* d = DVTS + (((size_t)b * 4 + hd) * 64 + dvb + 4 * h) * 2560 + s;
#pragma unroll
            for (int g = 0; g < 4; ++g)
#pragma unroll
              for (int j = 0; j < 4; ++j) d[(size_t)(8 * g + j) * 2560] = f2bf(v[4 * g + j]);
          }
        } } else if (nt < 1920) { if (MASK & 1) {
          ST_TILE32(CQ + (size_t)T * 384 + (nt - 1536), h, v, 1.f);
          { float sq = 0.f;
#pragma unroll
            for (int i = 0; i < 16; ++i) sq += v[i] * v[i];
            sq = xor32_sum(sq);
            if (h == 0) atomicAdd(SSQ + T, sq); }
        } } else if (nt < 2176) { if (MASK & 8) {
          ST_TILE32(CKVB + (size_t)T * 256 + (nt - 1920), h, v, 1.f);
          { float sq = 0.f;
#pragma unroll
            for (int i = 0; i < 16; ++i) sq += v[i] * v[i];
            sq = xor32_sum(sq);
            if (h == 0) atomicAdd(SSQ + 8192 + T, sq); }
          if (!smp) {
            float* o = CKVF + (size_t)T * 256 + (nt - 1920) + 4 * h;
#pragma unroll
            for (int g = 0; g < 4; ++g) { f32x4 t = {v[4 * g], v[4 * g + 1], v[4 * g + 2], v[4 * g + 3]}; *(f32x4*)(o + 8 * g) = t; }
          }
        } } else if (nt < 2208) { if (MASK & 16) {
          if (!smp) {
            float* o = out + OUT_KPE + (((size_t)b * 2 + l) * 256 + s) * 32 + 4 * h;
#pragma unroll
            for (int g = 0; g < 4; ++g) { f32x4 t = {v[4 * g], v[4 * g + 1], v[4 * g + 2], v[4 * g + 3]}; *(f32x4*)(o + 8 * g) = t; }
            for (int hh = 0; hh < 8; ++hh) {
              ST_TILE32(KMP + (((size_t)b * 8 + hh) * 256 + s) * 96 + 64, h, v, 1.f);
            }
          } else {
            rope16(v, s, h);
            for (int hh = 0; hh < 8; ++hh) {
              ST_TILE32(KMS + (((size_t)b * 8 + hh) * 2560 + s) * 96 + 64, h, v, 1.f);
            }
          }
        } }
      }
    }
  }
};
typedef EpiInT<31> EpiIn;

struct EpiNull { float* sink;
  DI void operator()(f32x16 (&acc)[2][2], int tb, int nb, int r, int h) const {
    float s = 0.f;
#pragma unroll
    for (int a = 0; a < 2; ++a)
#pragma unroll
      for (int b = 0; b < 2; ++b)
#pragma unroll
        for (int i = 0; i < 16; ++i) s += acc[a][b][i];
    if (s == 12345.678f) sink[tb + r] = s;
  }
};
struct EpiUq {
  bf16_t* QM; const float* ssq;
  DI void operator()(f32x16 (&acc)[2][2], int tb, int nb, int r, int h) const {
#pragma unroll
    for (int mi = 0; mi < 2; ++mi) {
      const int T = tb + mi * 32 + r; bool smp; int b, s; tok_decode(T, smp, b, s);
      const float sc = rsqrtf(ssq[T] * (1.f / 384.f) + 1e-6f) * QSC_MLA;
#pragma unroll
      for (int ni = 0; ni < 2; ++ni) {
        const int nt = nb + ni * 32; f32x16 v = acc[mi][ni];
        const int hh = nt / 96, dd0 = nt - hh * 96;
        if (dd0 == 64 && smp) rope16(v, s, h);
        const size_t base = smp ? (size_t)NPR * 768 + (((size_t)b * 8 + hh) * 2048 + s) * 96 : (((size_t)b * 8 + hh) * 256 + s) * 96;
        ST_TILE32(QM + base + dd0, h, v, sc);
      }
    }
  }
};

struct EpiUkv {
  int mode; bf16_t *KMP, *VMTP, *KMS, *VMTS;   const float* ssq;
  DI void operator()(f32x16 (&acc)[2][2], int tb, int nb, int r, int h) const {
    if (__builtin_amdgcn_readfirstlane(nb & 64)) {
#pragma unroll
      for (int mi = 0; mi < 2; ++mi) {
        const int R0 = __builtin_amdgcn_readfirstlane(tb) + mi * 32;
        bf16_t* vmt; int b, s0, S_all;
        if (mode == 0) {
          bool smp; tok_decode(R0, smp, b, s0);
          if (smp) { vmt = VMTS; S_all = 2560; } else { vmt = VMTP; S_all = 256; }
#pragma unroll
          for (int g = 0; g < 4; ++g) {
            const f32x4 q = *(const f32x4*)(ssq + R0 + 8 * g + 4 * h);
#pragma unroll
            for (int j = 0; j < 4; ++j) {
              const float sj = rsqrtf(q[j] * (1.f / 256.f) + 1e-6f);
              acc[mi][0][4 * g + j] *= sj; acc[mi][1][4 * g + j] *= sj;
            }
          }
        } else {
          const int lc = R0 >> 10; b = (R0 >> 9) & 1; s0 = 2048 + (R0 & 511);
          vmt = VMTS + (size_t)lc * N_VMTS; S_all = 2560;
        }
#pragma unroll
        for (int ni = 0; ni < 2; ++ni) {
          const int nt = nb + ni * 32, hh = nt >> 7, dv = (nt & 127) - 64 + r;
          ST_TILE32(vmt + (((size_t)b * 8 + hh) * 64 + dv) * S_all + s0, h, acc[mi][ni], 1.f);
        }
      }
      return;
    }
#pragma unroll
    for (int mi = 0; mi < 2; ++mi) {
      const int R = tb + mi * 32 + r;
      bf16_t *km, *vmt; int b, s, S_all; float sc;
      if (mode == 0) {
        bool smp; tok_decode(R, smp, b, s); sc = rsqrtf(ssq[R] * (1.f / 256.f) + 1e-6f);
        if (smp) { km = KMS; vmt = VMTS; S_all = 2560; } else { km = KMP; vmt = VMTP; S_all = 256; }
      } else {
        const int lc = R >> 10; b = (R >> 9) & 1; s = 2048 + (R & 511); sc = 1.f;
        km = KMS + (size_t)lc * N_KMS; vmt = VMTS + (size_t)lc * N_VMTS; S_all = 2560;
      }
#pragma unroll
      for (int ni = 0; ni < 2; ++ni) {
        const int nt = nb + ni * 32; const f32x16 v = acc[mi][ni];
        const int hh = nt >> 7, e0 = nt & 127;
        if (e0 < 64) {
          ST_TILE32(km + (((size_t)b * 8 + hh) * S_all + s) * 96 + e0, h, v, sc);
        } else {
          bf16_t* d = vmt + (((size_t)b * 8 + hh) * 64 + (e0 - 64) + 4 * h) * S_all + s;
#pragma unroll
          for (int g = 0; g < 4; ++g)
#pragma unroll
            for (int j = 0; j < 4; ++j) d[(size_t)(8 * g + j) * S_all] = f2bf(v[4 * g + j] * sc);
        }
      }
    }
  }
};

struct EpiRes {
  const float* xp; const float* xs; float* xz; const float* gate;
  DI void operator()(f32x16 (&acc)[2][2], int tb, int nb, int r, int h) const {
#pragma unroll
    for (int mi = 0; mi < 2; ++mi) {
      const int T = tb + mi * 32 + r;
      const int vi = T < NPR ? 0 : 1 + ((T - NPR) >> 11);
      const float* xr = T < NPR ? xp + (size_t)T * 1024 : xs + (size_t)(T - NPR) * 1024;
      const float* gp = gate + vi * 6144;
      float* zo = xz + (size_t)T * 1024;
#pragma unroll
      for (int ni = 0; ni < 2; ++ni) {
        const f32x16 v = acc[mi][ni];
#pragma unroll
        for (int g = 0; g < 4; ++g) {
          const int n = nb + ni * 32 + 8 * g + 4 * h;
          const f32x4 x = *(const f32x4*)(xr + n), gg = *(const f32x4*)(gp + n);
          f32x4 z = {ALPHA * x[0] + gg[0] * v[4 * g], ALPHA * x[1] + gg[1] * v[4 * g + 1], ALPHA * x[2] + gg[2] * v[4 * g + 2], ALPHA * x[3] + gg[3] * v[4 * g + 3]};
          *(f32x4*)(zo + n) = z;
        }
      }
    }
  }
};


template <int RBF, int OBF> struct EpiResLN {
  const float* xp; const float* xs; float* xout; bf16_t* Hout; const float* gate; const float* lng; const float* lnb; const float* modsh;
  unsigned long long* exch; unsigned* cnt; char* smem; int mt, nt;
  DI void operator()(f32x16 (&acc)[2][2], int tb, int nb, int r, int h) const {
    const int tid = my_tid();
    float* part = (float*)(smem + 65536);
    float* stat = (float*)(smem + 65536 + 2048);
    const int wm = (tb >> 6) & 1, wn = (nb >> 6) & 1;
    const int vi_t = tb < NPR ? 0 : 1 + ((tb - NPR) >> 11);
    {
      f32x4 gg[2][4];
      const float* gp = gate + vi_t * 6144 + nb + 4 * h;
#pragma unroll
      for (int ni = 0; ni < 2; ++ni)
#pragma unroll
        for (int g = 0; g < 4; ++g) gg[ni][g] = *(const f32x4*)(gp + ni * 32 + 8 * g);
#pragma unroll
      for (int mi = 0; mi < 2; ++mi) {
        const int T = tb + mi * 32 + r;
        f32x4 xv[2][4];
        if (RBF) {
          const bf16_t* xr16 = (const bf16_t*)xp + (size_t)T * 1024 + nb + 4 * h;
#pragma unroll
          for (int ni = 0; ni < 2; ++ni)
#pragma unroll
            for (int g = 0; g < 4; ++g) {
              const u32x2 q = *(const u32x2*)(xr16 + ni * 32 + 8 * g);
              xv[ni][g] = (f32x4){__uint_as_float(q[0] << 16), __uint_as_float(q[0] & 0xffff0000u), __uint_as_float(q[1] << 16), __uint_as_float(q[1] & 0xffff0000u)};
            }
        } else {
          const float* xr = (T < NPR ? xp + (size_t)T * 1024 : xs + (size_t)(T - NPR) * 1024) + nb + 4 * h;
#pragma unroll
          for (int ni = 0; ni < 2; ++ni)
#pragma unroll
            for (int g = 0; g < 4; ++g) xv[ni][g] = *(const f32x4*)(xr + ni * 32 + 8 * g);
        }
        float s1 = 0.f, s2 = 0.f;
#pragma unroll
        for (int ni = 0; ni < 2; ++ni)
#pragma unroll
          for (int g = 0; g < 4; ++g)
#pragma unroll
            for (int j = 0; j < 4; ++j) { const float z = ALPHA * xv[ni][g][j] + gg[ni][g][j] * acc[mi][ni][4 * g + j]; acc[mi][ni][4 * g + j] = z; s1 += z; s2 += z * z; }
        s1 = xor32_sum(s1); s2 = xor32_sum(s2);
        if (h == 0) { const int row = wm * 64 + mi * 32 + r; part[(wn * 128 + row) * 2] = s1; part[(wn * 128 + row) * 2 + 1] = s2; }
      }
    }
    __syncthreads();
    if (tid < 128) {
      const float a = part[tid * 2] + part[(128 + tid) * 2], b = part[tid * 2 + 1] + part[(128 + tid) * 2 + 1];
      const unsigned long long pk = ((unsigned long long)__float_as_uint(b) << 32) | (unsigned long long)__float_as_uint(a);
      __hip_atomic_store(exch + ((size_t)mt * 8 + nt) * 128 + tid, pk, __ATOMIC_RELAXED, __HIP_MEMORY_SCOPE_AGENT);
    }
    asm volatile("s_waitcnt vmcnt(0)" ::: "memory");
    __syncthreads();
    if (tid == 0) {
      __hip_atomic_fetch_add(cnt + 64 * mt, 1u, __ATOMIC_RELAXED, __HIP_MEMORY_SCOPE_AGENT);
      unsigned sp = 0;
      while (__hip_atomic_load(cnt + 64 * mt, __ATOMIC_RELAXED, __HIP_MEMORY_SCOPE_AGENT) < 8u) { __builtin_amdgcn_s_sleep(1); if (++sp > (1u << 22)) break; }
    }
    __syncthreads();
    if (tid < 128) {
      float a = 0.f, b = 0.f;
#pragma unroll
      for (int q = 0; q < 8; ++q) {
        const unsigned long long pk = __hip_atomic_load(exch + ((size_t)mt * 8 + q) * 128 + tid, __ATOMIC_RELAXED, __HIP_MEMORY_SCOPE_AGENT);
        a += __uint_as_float((unsigned)pk); b += __uint_as_float((unsigned)(pk >> 32));
      }
      const float mean = a * (1.f / 1024.f);
      const float var = fmaxf(b * (1.f / 1024.f) - mean * mean, 0.f);
      stat[tid * 2] = mean; stat[tid * 2 + 1] = rsqrtf(var + 1e-5f);
    }
    __syncthreads();
    {
      const float* mp = modsh + vi_t * 6144 + nb + 4 * h;
      float mean[2], rstd[2];
#pragma unroll
      for (int mi = 0; mi < 2; ++mi) { const int row = wm * 64 + mi * 32 + r; mean[mi] = stat[row * 2]; rstd[mi] = stat[row * 2 + 1]; }
#pragma unroll
      for (int ni = 0; ni < 2; ++ni) {
        f32x4 gg[4], bv[4], sh[4], sc[4];
#pragma unroll
        for (int g = 0; g < 4; ++g) {
          gg[g] = *(const f32x4*)(lng + nb + 4 * h + ni * 32 + 8 * g); bv[g] = *(const f32x4*)(lnb + nb + 4 * h + ni * 32 + 8 * g);
          if (Hout) { sh[g] = *(const f32x4*)(mp + ni * 32 + 8 * g); sc[g] = *(const f32x4*)(mp + 1024 + ni * 32 + 8 * g); }
        }
#pragma unroll
        for (int mi = 0; mi < 2; ++mi) {
          const int T = tb + mi * 32 + r;
          float hv[16], xq[16];
#pragma unroll
          for (int g = 0; g < 4; ++g) {
            const int n = nb + ni * 32 + 8 * g + 4 * h;
            f32x4 x;
#pragma unroll
            for (int j = 0; j < 4; ++j) x[j] = (acc[mi][ni][4 * g + j] - mean[mi]) * rstd[mi] * gg[g][j] + bv[g][j];
            if (OBF) {
#pragma unroll
              for (int j = 0; j < 4; ++j) xq[4 * g + j] = x[j];
            } else *(f32x4*)(xout + (size_t)T * 1024 + n) = x;
            if (Hout) {
#pragma unroll
              for (int j = 0; j < 4; ++j) hv[4 * g + j] = x[j] * (sc[g][j] + 1.f) + sh[g][j];
            }
          }
          if (Hout) ST_TILE32(Hout + (size_t)T * 1024 + nb + ni * 32, h, hv, 1.f);
          if (OBF) ST_TILE32((bf16_t*)xout + (size_t)T * 1024 + nb + ni * 32, h, xq, 1.f);
        }
      }
    }
  }
};

struct EpiFfUp {
  bf16_t* ACT;
  DI void operator()(f32x16 (&acc)[2][2], int tb, int nb, int r, int h) const {
#pragma unroll
    for (int mi = 0; mi < 2; ++mi) {
      const int T = tb + mi * 32 + r;
      float o[16];
#pragma unroll
      for (int i = 0; i < 16; ++i) { const float ga = acc[mi][0][i], up = acc[mi][1][i]; o[i] = ga * up * __builtin_amdgcn_rcpf(1.f + __builtin_amdgcn_exp2f(-LOG2E * ga)); }
      ST_TILE32(ACT + (size_t)T * DFF + (nb >> 1), h, o, 1.f);
    }
  }
};

template <bool LN>
DI void ln_mod_pass(const float* sp, const float* ss, float* xdst, bf16_t* hdst, const float* g, const float* bb, const float* mod_sh  ) {
  const int tid_ = my_tid(); const int lane = tid_ & 63, w = tid_ >> 6;
  for (int T = blockIdx.x * 4 + w; T < NTOK; T += gridDim.x * 4) {
    const float* src = T < NPR ? sp + (size_t)T * 1024 : ss + (size_t)(T - NPR) * 1024;
    f32x4 v[4];
#pragma unroll
    for (int i = 0; i < 4; ++i) v[i] = *(const f32x4*)(src + lane * 4 + 256 * i);
    if (LN) {
      float s = 0.f;
#pragma unroll
      for (int i = 0; i < 4; ++i) s += (v[i][0] + v[i][1]) + (v[i][2] + v[i][3]);
#pragma unroll
      for (int o = 32; o >= 1; o >>= 1) s += __shfl_xor(s, o);
      const float mu = s * (1.f / 1024.f);
      float q = 0.f;
#pragma unroll
      for (int i = 0; i < 4; ++i) { v[i] = v[i] - mu; q += (v[i][0] * v[i][0] + v[i][1] * v[i][1]) + (v[i][2] * v[i][2] + v[i][3] * v[i][3]); }
#pragma unroll
      for (int o = 32; o >= 1; o >>= 1) q += __shfl_xor(q, o);
      const float rstd = rsqrtf(q * (1.f / 1024.f) + 1e-5f);
#pragma unroll
      for (int i = 0; i < 4; ++i) {
        const f32x4 gg = *(const f32x4*)(g + lane * 4 + 256 * i), bv = *(const f32x4*)(bb + lane * 4 + 256 * i);
        v[i] = v[i] * rstd * gg + bv;
        *(f32x4*)(xdst + (size_t)T * 1024 + lane * 4 + 256 * i) = v[i];
      }
    }
    if (hdst) {
      const int vi = T < NPR ? 0 : 1 + ((T - NPR) >> 11);
      const float* mp = mod_sh + vi * 6144;
#pragma unroll
      for (int i = 0; i < 4; ++i) {
        const f32x4 sh = *(const f32x4*)(mp + lane * 4 + 256 * i), sc = *(const f32x4*)(mp + 1024 + lane * 4 + 256 * i);
        const f32x4 o = v[i] * (sc + 1.f) + sh;
        st4bf(hdst + (size_t)T * 1024 + lane * 4 + 256 * i, o[0], o[1], o[2], o[3]);
      }
    }
  }
}

template <int MODE>
DI void attn_unit(const bf16_t* __restrict__ Q, size_t qmap, const bf16_t* __restrict__ Kg, size_t kmap, const bf16_t* __restrict__ VT, int S_all, int nkeys,
                  bf16_t* __restrict__ Yout, float lam, const float* __restrict__ normw, float oscale, char* smem,
                  float* ows_pair, unsigned* flag, int mapidx, int* s_flag) {
  constexpr bool DIFF = MODE == 1, D32 = MODE != 0;
  constexpr int DQK = D32 ? 32 : 96, NKS = DQK / 16, NMAP = DIFF ? 2 : 1, KROWB = D32 ? 80 : 208;
  constexpr int KREG = NMAP * 64 * KROWB, STAGE = 24576, KCH = DQK / 8  , NKLD = NMAP * 64 * KCH / 256;
  const int tid = my_tid(), lane = tid & 63, w = tid >> 6, r = lane & 31, h = lane >> 5;
  bf16x8 qf[NMAP][NKS];
#pragma unroll
  for (int m = 0; m < NMAP; ++m)
#pragma unroll
    for (int ks = 0; ks < NKS; ++ks) qf[m][ks] = *(const bf16x8*)(Q + m * qmap + (size_t)(w * 32 + r) * DQK + ks * 16 + 8 * h);
#pragma unroll
  for (int m = 0; m < NMAP; ++m)
#pragma unroll
    for (int ks = 0; ks < NKS; ++ks) asm volatile("" :: "v"(qf[m][ks]));
  f32x16 O[NMAP][2];
  float mrun[NMAP], lrun[NMAP];
#pragma unroll
  for (int m = 0; m < NMAP; ++m) { mrun[m] = -1e30f; lrun[m] = 0.f;
#pragma unroll
    for (int dt = 0; dt < 2; ++dt)
#pragma unroll
      for (int i = 0; i < 16; ++i) O[m][dt][i] = 0.f; }
  u32x4 rk[NKLD], rv[2];
  const int vdv = tid >> 3, vch = tid & 7;
#define ATT_GLOAD(key0) do { \
    _Pragma("unroll") for (int i = 0; i < NKLD; ++i) { const int idx = tid + 256 * i; int go; \
      if (D32) { go = ((idx >> 2) & 63) * 32 + (idx & 3) * 8; } else { const int row = idx / 12; go = row * 96 + (idx - row * 12) * 8; } \
      rk[i] = *(const u32x4*)(Kg + (DIFF ? (size_t)i * kmap : 0) + (size_t)(key0) * DQK + go); } \
    _Pragma("unroll") for (int i = 0; i < 2; ++i) rv[i] = *(const u32x4*)(VT + (size_t)(vdv + 32 * i) * S_all + (key0) + vch * 8); } while (0)
#define ATT_SWRITE(st) do { char* base_ = smem + (st) * STAGE; \
    _Pragma("unroll") for (int i = 0; i < NKLD; ++i) { const int idx = tid + 256 * i; int so; \
      if (D32) { so = i * 64 * KROWB + ((idx >> 2) & 63) * KROWB + (idx & 3) * 16; } else { const int row = idx / 12; so = row * KROWB + (idx - row * 12) * 16; } \
      *(u32x4*)(base_ + so) = rk[i]; } \
    _Pragma("unroll") for (int i = 0; i < 2; ++i) { char* d_ = base_ + KREG + (vdv + 32 * i) * 136 + vch * 16; \
      u32x2 lo_ = {rv[i][0], rv[i][1]}, hi_ = {rv[i][2], rv[i][3]}; *(u32x2*)d_ = lo_; *(u32x2*)(d_ + 8) = hi_; } } while (0)
  ATT_GLOAD(0); ATT_SWRITE(0); __syncthreads();
  const int nt = nkeys >> 6;
  for (int t = 0; t < nt; ++t) {
    const char* cur = smem + (t & 1) * STAGE;
    if (t + 1 < nt) ATT_GLOAD((t + 1) * 64);
#pragma unroll
    for (int m = 0; m < NMAP; ++m) {
      f32x16 S[2];
#pragma unroll
      for (int kt = 0; kt < 2; ++kt)
#pragma unroll
        for (int i = 0; i < 16; ++i) S[kt][i] = 0.f;
      {
        bf16x8 kf[NKS][2];
#pragma unroll
        for (int kt = 0; kt < 2; ++kt) kf[0][kt] = *(const bf16x8*)(cur + m * 64 * KROWB + (kt * 32 + r) * KROWB + (8 * h) * 2);
#pragma unroll
        for (int ks = 0; ks < NKS; ++ks) {
          if (ks + 1 < NKS) {
#pragma unroll
            for (int kt = 0; kt < 2; ++kt) kf[ks + 1][kt] = *(const bf16x8*)(cur + m * 64 * KROWB + (kt * 32 + r) * KROWB + ((ks + 1) * 16 + 8 * h) * 2);
          }
          __builtin_amdgcn_sched_barrier(0);
#pragma unroll
          for (int kt = 0; kt < 2; ++kt) S[kt] = MFMA(kf[ks][kt], qf[m][ks], S[kt]);
          __builtin_amdgcn_sched_barrier(0);
        }
      }
      float mx = S[0][0];
#pragma unroll
      for (int kt = 0; kt < 2; ++kt)
#pragma unroll
        for (int i = 0; i < 16; ++i) mx = fmaxf(mx, S[kt][i]);
      mx = xor32_max(mx);
      const float mnew = fmaxf(mrun[m], mx);
      const float alpha = __builtin_amdgcn_exp2f(mrun[m] - mnew);
      mrun[m] = mnew;
      f32x2 ls2 = {0.f, 0.f};
      const f32x2 mneg = {-mnew, -mnew};
      bf16x8 pf[2][2];
#pragma unroll
      for (int kt = 0; kt < 2; ++kt) {
        unsigned pk[8];
#pragma unroll
        for (int i = 0; i < 8; ++i) {
          f32x2 v = {S[kt][2 * i], S[kt][2 * i + 1]};
          v = v + mneg;
          v.x = __builtin_amdgcn_exp2f(v.x); v.y = __builtin_amdgcn_exp2f(v.y);
          ls2 = ls2 + v;
          pk[i] = pack2(v.x, v.y);
        }
#pragma unroll
        for (int s2 = 0; s2 < 2; ++s2) {
          u32x4 pq = {pk[4 * s2], pk[4 * s2 + 1], pk[4 * s2 + 2], pk[4 * s2 + 3]};
          pf[kt][s2] = __builtin_bit_cast(bf16x8, pq);
        }
      }
      const float ls = ls2.x + ls2.y;
      lrun[m] = lrun[m] * alpha + ls;
#pragma unroll
      for (int dt = 0; dt < 2; ++dt)
#pragma unroll
        for (int i = 0; i < 16; ++i) O[m][dt][i] *= alpha;
#pragma unroll
      for (int kt = 0; kt < 2; ++kt)
#pragma unroll
        for (int s2 = 0; s2 < 2; ++s2) {
          bf16x8 vf[2];
#pragma unroll
          for (int dt = 0; dt < 2; ++dt) {
            const char* a = cur + KREG + (dt * 32 + r) * 136 + (kt * 32 + 16 * s2 + 4 * h) * 2;
            const s16x4 lo = *(const s16x4*)a, hi = *(const s16x4*)(a + 16);
            vf[dt] = __builtin_shufflevector(lo, hi, 0, 1, 2, 3, 4, 5, 6, 7);
          }
#pragma unroll
          for (int dt = 0; dt < 2; ++dt) O[m][dt] = MFMA(vf[dt], pf[kt][s2], O[m][dt]);
        }
      if (NMAP == 2) __builtin_amdgcn_sched_barrier(0);
    }
    if (t + 1 < nt) ATT_SWRITE((t + 1) & 1);
    __syncthreads();
  }
#undef ATT_GLOAD
#undef ATT_SWRITE
  float linv[NMAP];
#pragma unroll
  for (int m = 0; m < NMAP; ++m) { const float lt = lrun[m] + __shfl_xor(lrun[m], 32); linv[m] = 1.f / lt; }
  bf16_t* yo = Yout + (size_t)(w * 32 + r) * 1024 + 4 * h;
  if (MODE == 2) {
    float* mine = ows_pair + ((size_t)mapidx * 128 + w * 32 + r) * 64 + 4 * h;
#pragma unroll
    for (int dt = 0; dt < 2; ++dt)
#pragma unroll
      for (int g = 0; g < 4; ++g) {
        f32x4 o = {O[0][dt][4 * g] * linv[0], O[0][dt][4 * g + 1] * linv[0], O[0][dt][4 * g + 2] * linv[0], O[0][dt][4 * g + 3] * linv[0]};
#pragma unroll
        for (int j = 0; j < 4; ++j) O[0][dt][4 * g + j] = o[j];
        *(f32x4*)(mine + dt * 32 + 8 * g) = o;
      }
    asm volatile("s_waitcnt vmcnt(0)" ::: "memory");
    __syncthreads();
    if (tid == 0) {
      __builtin_amdgcn_fence(__ATOMIC_RELEASE, "agent");
      asm volatile("s_waitcnt vmcnt(0)" ::: "memory");
      const unsigned old = __hip_atomic_fetch_add(flag, 1u, __ATOMIC_RELAXED, __HIP_MEMORY_SCOPE_AGENT);
      if (old == 1u) { __builtin_amdgcn_fence(__ATOMIC_ACQUIRE, "agent"); asm volatile("s_waitcnt vmcnt(0)" ::: "memory"); }
      *s_flag = (int)old;
    }
    __syncthreads();
    if (*s_flag == 1) {
      const float* oth = ows_pair + ((size_t)(1 - mapidx) * 128 + w * 32 + r) * 64 + 4 * h;
      const float c_mine = mapidx == 0 ? 1.f : -lam, c_oth = mapidx == 0 ? -lam : 1.f;
      float ssq = 0.f;
#pragma unroll
      for (int dt = 0; dt < 2; ++dt)
#pragma unroll
        for (int g = 0; g < 4; ++g) {
          const f32x4 po = *(const f32x4*)(oth + dt * 32 + 8 * g);
#pragma unroll
          for (int j = 0; j < 4; ++j) { const float o = c_mine * O[0][dt][4 * g + j] + c_oth * po[j]; O[0][dt][4 * g + j] = o; ssq += o * o; }
        }
      ssq = xor32_sum(ssq);
      const float rn = rsqrtf(ssq * (1.f / 64.f) + 1e-6f) * oscale;
#pragma unroll
      for (int dt = 0; dt < 2; ++dt) {
#pragma unroll
        for (int g = 0; g < 4; ++g) {
          const f32x4 nw = *(const f32x4*)(normw + dt * 32 + 8 * g + 4 * h);
#pragma unroll
          for (int j = 0; j < 4; ++j) O[0][dt][4 * g + j] *= rn * nw[j];
        }
        ST_TILE32(yo - 4 * h + dt * 32, h, O[0][dt], 1.f);
      }
    }
  } else if (DIFF) {
    float ssq = 0.f;
#pragma unroll
    for (int dt = 0; dt < 2; ++dt)
#pragma unroll
      for (int i = 0; i < 16; ++i) { const float o = O[0][dt][i] * linv[0] - lam * (O[NMAP - 1][dt][i] * linv[NMAP - 1]); O[0][dt][i] = o; ssq += o * o; }
    ssq = xor32_sum(ssq);
    const float rn = rsqrtf(ssq * (1.f / 64.f) + 1e-6f) * oscale;
#pragma unroll
    for (int dt = 0; dt < 2; ++dt) {
#pragma unroll
      for (int g = 0; g < 4; ++g) {
        const f32x4 nw = *(const f32x4*)(normw + dt * 32 + 8 * g + 4 * h);
#pragma unroll
        for (int j = 0; j < 4; ++j) O[0][dt][4 * g + j] *= rn * nw[j];
      }
      ST_TILE32(yo - 4 * h + dt * 32, h, O[0][dt], 1.f);
    }
  } else {
#pragma unroll
    for (int dt = 0; dt < 2; ++dt) ST_TILE32(yo - 4 * h + dt * 32, h, O[0][dt], linv[0]);
  }
}


#define XB_TMO      128
#define XB_XCNT(j)  (256  + 64 * (j))
#define XB_XSUB(j)  (1280 + 64 * (j))
#define XB_XGEN(j)  (2304 + 64 * (j))
#define XB_TOP      3328
#define XB_TOPGEN   3392
#define XCD_BAR_WORDS 3456
#define XB_SPIN_CAP (1u << 18)
#define LAS __attribute__((address_space(3)))
DI unsigned xb_ld(unsigned* p)              { return __hip_atomic_load(p, __ATOMIC_RELAXED, __HIP_MEMORY_SCOPE_AGENT); }
DI unsigned xb_add(unsigned* p, unsigned v) { return __hip_atomic_fetch_add(p, v, __ATOMIC_RELAXED, __HIP_MEMORY_SCOPE_AGENT); }
DI unsigned xb_xcc_id() { return (unsigned)__builtin_amdgcn_s_getreg((3 << 11) | 20) & 0xFu; }
#define XB_SPIN(cond, bar) do { unsigned _sp = 0; while (cond) { __builtin_amdgcn_s_sleep(1); \
    if ((++_sp & 255u) == 0u) { if (xb_ld(&(bar)[XB_TMO])) break; if (_sp > XB_SPIN_CAP) { atomicAdd(&(bar)[XB_TMO], 1u); break; } } } } while (0)
struct XcdBarrier { unsigned* bar; unsigned x; volatile LAS unsigned* st; };
DI XcdBarrier xcd_barrier_post(unsigned* bar, volatile LAS unsigned* st) {
  XcdBarrier b; b.bar = bar; b.x = xb_xcc_id(); b.st = st;
  if (threadIdx.x == 0) (void)xb_add(&bar[XB_XCNT(b.x)], 1u);
  return b;
}
DI void xcd_barrier_complete(unsigned* bar, unsigned x, unsigned& nloc, unsigned& nx) {
  const unsigned G = gridDim.x * gridDim.y * gridDim.z;
  unsigned sum, cnt, mine, sp = 0u;
  for (;;) {
    sum = 0u; cnt = 0u; mine = 0u;
#pragma unroll
    for (unsigned j = 0; j < 16; ++j) { const unsigned c = xb_ld(&bar[XB_XCNT(j)]); sum += c; cnt += (c > 0u) ? 1u : 0u; mine = (j == x) ? c : mine; }
    if (sum == G) break;
    __builtin_amdgcn_s_sleep(1);
    if ((++sp & 255u) == 0u) { if (xb_ld(&bar[XB_TMO])) break; if (sp > XB_SPIN_CAP) { atomicAdd(&bar[XB_TMO], 1u); break; } }
  }
  nloc = mine > 0u ? mine : 1u; nx = cnt > 0u ? cnt : 1u;
}
DI void xcd_barrier(const XcdBarrier& b) {
  asm volatile("s_waitcnt vmcnt(0)" ::: "memory");
  __syncthreads();
  if (threadIdx.x == 0) {
    unsigned* bar = b.bar;
    __builtin_amdgcn_s_waitcnt(0);
    unsigned nloc = b.st[0], nx = b.st[1];
    if (nloc == 0u) { xcd_barrier_complete(bar, b.x, nloc, nx); b.st[0] = nloc; b.st[1] = nx; }
    const unsigned old = xb_add(&bar[XB_XSUB(b.x)], 1u);
    const unsigned gen = old / nloc;
    if (old + 1u == (gen + 1u) * nloc) {
      __builtin_amdgcn_fence(__ATOMIC_RELEASE, "agent");
      asm volatile("s_waitcnt vmcnt(0)" ::: "memory");
      const unsigned og = xb_add(&bar[XB_TOP], 1u);
      const unsigned tg = og / nx;
      if (og + 1u == (tg + 1u) * nx) xb_add(&bar[XB_TOPGEN], 1u);
      else XB_SPIN(xb_ld(&bar[XB_TOPGEN]) == tg, bar);
      __builtin_amdgcn_fence(__ATOMIC_ACQUIRE, "agent");
      xb_add(&bar[XB_XGEN(b.x)], 1u);
      asm volatile("s_waitcnt vmcnt(0)" ::: "memory");
    } else {
      XB_SPIN(xb_ld(&bar[XB_XGEN(b.x)]) == gen, bar);
      __builtin_amdgcn_fence(__ATOMIC_ACQUIRE, "agent");
      asm volatile("s_waitcnt vmcnt(0)" ::: "memory");
    }
  }
  __syncthreads();
}

DI void transpose_tile(const float* __restrict__ src, int ldn, int nvalid, bf16_t* __restrict__ dst, int K, const float* __restrict__ rowscale, int mode, int kt, int nt, float* tile) {
  const int tid = my_tid();
  {
    const int c4 = tid & 63, r0 = tid >> 6;
    const int n = nt * 256 + c4 * 4;
    f32x4 v[16];
#pragma unroll
    for (int i = 0; i < 16; ++i) {
      const int k = kt * 64 + r0 + 4 * i;
      v[i] = (f32x4){0.f, 0.f, 0.f, 0.f};
      if (n < nvalid) v[i] = __builtin_nontemporal_load((const f32x4*)(src + (size_t)k * ldn + n));
    }
#pragma unroll
    for (int i = 0; i < 16; ++i) {
      const int kl = r0 + 4 * i;
      f32x4 x = v[i];
      if (rowscale) { const float sc = rowscale[kt * 64 + kl]; x = x * sc; }
      float* t = tile + kl * 257 + c4 * 4;
      t[0] = x[0]; t[1] = x[1]; t[2] = x[2]; t[3] = x[3];
    }
  }
  __syncthreads();
  {
    const int q = tid & 7, nr = tid >> 3;
#pragma unroll
    for (int i = 0; i < 8; ++i) {
      const int nl = nr + 32 * i, n = nt * 256 + nl;
      int drow = n;
      if (mode == 1) drow = (n >> 5) * 64 + (n & 31);
      else if (mode == 2) drow = (n >> 5) * 64 + 32 + (n & 31);
      float v[8];
#pragma unroll
      for (int j = 0; j < 8; ++j) v[j] = tile[(q * 8 + j) * 257 + nl];
      u32x4 a = {pack2(v[0], v[1]), pack2(v[2], v[3]), pack2(v[4], v[5]), pack2(v[6], v[7])};
      *(u32x4*)(dst + (size_t)drow * K + kt * 64 + q * 8) = a;
    }
  }
  __syncthreads();
}

DI void adaln_task(const Params& p, int l, int kc, float* PART, float* sm, unsigned* done) {
  const int tid = my_tid();
  if (tid < 48) {
    const int v = tid >> 4, k = kc * 16 + (tid & 15);
    const float x = v == 0 ? p.c_ctx[k] : p.c[(v - 1) * 1024 + k];
    sm[tid] = x / (1.f + __expf(-x));
  }
  __syncthreads();
  f32x4 a0[6], a1[6], a2[6];
#pragma unroll
  for (int i = 0; i < 6; ++i) { a0[i] = (f32x4){0.f, 0.f, 0.f, 0.f}; a1[i] = a0[i]; a2[i] = a0[i]; }
  const float* wp = p.w_ada + (size_t)l * 1024 * 6144 + (size_t)(kc * 16) * 6144 + tid * 4;
#pragma unroll 4
  for (int kk = 0; kk < 16; ++kk) {
    f32x4 w[6];
#pragma unroll
    for (int i = 0; i < 6; ++i) w[i] = __builtin_nontemporal_load((const f32x4*)(wp + (size_t)kk * 6144 + i * 1024));
    const float s0 = sm[kk], s1 = sm[16 + kk], s2 = sm[32 + kk];
#pragma unroll
    for (int i = 0; i < 6; ++i) { a0[i] += w[i] * s0; a1[i] += w[i] * s1; a2[i] += w[i] * s2; }
  }
  float* m0 = PART + (((size_t)l * 64 + kc) * 3) * 6144 + tid * 4;
#pragma unroll
  for (int i = 0; i < 6; ++i) {
    *(f32x4*)(m0 + i * 1024) = a0[i];
    *(f32x4*)(m0 + 6144 + i * 1024) = a1[i];
    *(f32x4*)(m0 + 2 * 6144 + i * 1024) = a2[i];
  }
  asm volatile("s_waitcnt vmcnt(0)" ::: "memory");
  __syncthreads();
  if (tid == 0) {
    __builtin_amdgcn_fence(__ATOMIC_RELEASE, "agent");
    asm volatile("s_waitcnt vmcnt(0)" ::: "memory");
    __hip_atomic_fetch_add(done + l, 1u, __ATOMIC_RELAXED, __HIP_MEMORY_SCOPE_AGENT);
  }
}

DI void adaln_reduce(const Params& p, int chunk, const float* PART, float* MOD, unsigned* done, int rep) {
  const int tid = my_tid();
  const int l = chunk / 72, rem = chunk - l * 72, v = rem / 24, col = (rem - v * 24) * 256 + tid;
  if (tid == 0) {
    unsigned sp = 0;
    while (__hip_atomic_load(done + l, __ATOMIC_RELAXED, __HIP_MEMORY_SCOPE_AGENT) < 64u * (unsigned)(rep + 1)) { __builtin_amdgcn_s_sleep(2); if (++sp > (1u << 22)) break; }
    __builtin_amdgcn_fence(__ATOMIC_ACQUIRE, "agent");
    asm volatile("s_waitcnt vmcnt(0)" ::: "memory");
  }
  __syncthreads();
  const float* pp = PART + ((size_t)l * 64 * 3 + v) * 6144 + col;
  float s0 = 0.f, s1 = 0.f, s2 = 0.f, s3 = 0.f;
#pragma unroll 4
  for (int kc = 0; kc < 64; kc += 4) {
    s0 += pp[(size_t)(kc + 0) * 3 * 6144]; s1 += pp[(size_t)(kc + 1) * 3 * 6144]; s2 += pp[(size_t)(kc + 2) * 3 * 6144]; s3 += pp[(size_t)(kc + 3) * 3 * 6144];
  }
  MOD[((size_t)l * 3 + v) * 6144 + col] = (s0 + s1) + (s2 + s3) + p.b_ada[l * 6144 + col];
}

__global__ void __launch_bounds__(256, 2) mega(Params p) {
  __shared__ __attribute__((aligned(16))) char smem[SMEM_BYTES];
  __shared__ int s_unit;
  __shared__ int s_flag;
  cg::grid_group grid = cg::this_grid();
  if (p.ws == nullptr) grid.sync();
  __shared__ uint4 xb_words;
  if (threadIdx.x == 0) xb_words = make_uint4(0u, 0u, 0u, 0u);
  __syncthreads();
  const XcdBarrier xbar = xcd_barrier_post((unsigned*)(p.ws + O_BAR), (volatile LAS unsigned*)&xb_words);
#define GSYNC() xcd_barrier(xbar)
  int tid = threadIdx.x;
  char* ws = p.ws;
  bf16_t* WIN = (bf16_t*)(ws + O_WIN); bf16_t* WUQ = (bf16_t*)(ws + O_WUQ); bf16_t* WUKVN = (bf16_t*)(ws + O_WUKVN); bf16_t* WUKVC = (bf16_t*)(ws + O_WUKVC);
  bf16_t* WOUT = (bf16_t*)(ws + O_WOUT); bf16_t* W13 = (bf16_t*)(ws + O_W13); bf16_t* W2 = (bf16_t*)(ws + O_W2);
  bf16_t* H = (bf16_t*)(ws + O_H); bf16_t* DKP = (bf16_t*)(ws + O_DKP); bf16_t* DKS = (bf16_t*)(ws + O_DKS); bf16_t* DVTP = (bf16_t*)(ws + O_DVTP);
  bf16_t* DVTS = (bf16_t*)(ws + O_DVTS); bf16_t* KMP = (bf16_t*)(ws + O_KMP); bf16_t* KMS = (bf16_t*)(ws + O_KMS); bf16_t* VMTP = (bf16_t*)(ws + O_VMTP);
  bf16_t* VMTS = (bf16_t*)(ws + O_VMTS); bf16_t* CKVC = (bf16_t*)(ws + O_CKVC); float* MOD = (float*)(ws + O_MOD); float* CKVF = (float*)(ws + O_CKVF);
  float* XZ = (float*)(ws + O_XZ); int* CTR = (int*)(ws + O_CTR);
  bf16_t* AX = (bf16_t*)(ws + O_AX); bf16_t* DQ = (bf16_t*)(ws + O_DQ); bf16_t* CQ = (bf16_t*)(ws + O_CQ); bf16_t* CKVB = (bf16_t*)(ws + O_CKVB);
  bf16_t* QM = (bf16_t*)(ws + O_QM); bf16_t* Y = (bf16_t*)(ws + O_Y); bf16_t* ACT = (bf16_t*)(ws + O_ACT);
  const int G = gridDim.x, bid = blockIdx.x;

  for (int rep = 0; rep < REP_P0; ++rep) {
  for (int t = bid; t < 128 + 2 * 786; t += G) {
    if (t < 128) { adaln_task(p, t >> 6, t & 63, (float*)(ws + O_PART), (float*)smem, (unsigned*)(CTR + 4)); continue; }
    int u = t - 128; const int l = u / 786; u -= l * 786;
    float* tile = (float*)smem;
    if (u < 144) { transpose_tile(p.w_in + (size_t)l * 1024 * INC, INC, INC, WIN + (size_t)l * INP * 1024, 1024, nullptr, 0, u / 9, u % 9, tile); continue; }
    u -= 144;
    if (u < 18) { transpose_tile(p.w_uq + (size_t)l * 384 * 768, 768, 768, WUQ + (size_t)l * 768 * 384, 384, p.q_norm_w + l * 384, 0, u / 3, u % 3, tile); continue; }
    u -= 18;
    if (u < 16) { transpose_tile(p.w_ukv + (size_t)l * 256 * 1024, 1024, 1024, WUKVN + (size_t)l * 1024 * 256, 256, p.kv_norm_w + l * 256, 0, u / 4, u % 4, tile); continue; }
    u -= 16;
    if (u < 16) { transpose_tile(p.w_ukv + (size_t)l * 256 * 1024, 1024, 1024, WUKVC + (size_t)l * 1024 * 256, 256, nullptr, 0, u / 4, u % 4, tile); continue; }
    u -= 16;
    if (u < 64) { transpose_tile(p.w_out + (size_t)l * 1024 * 1024, 1024, 1024, WOUT + (size_t)l * 1024 * 1024, 1024, nullptr, 0, u / 4, u % 4, tile); continue; }
    u -= 64;
    if (u < 176) { transpose_tile(p.w_ff1 + (size_t)l * 1024 * DFF, DFF, DFF, W13 + (size_t)l * 5632 * 1024, 1024, nullptr, 1, u / 11, u % 11, tile); continue; }
    u -= 176;
    if (u < 176) { transpose_tile(p.w_ff3 + (size_t)l * 1024 * DFF, DFF, DFF, W13 + (size_t)l * 5632 * 1024, 1024, nullptr, 2, u / 11, u % 11, tile); continue; }
    u -= 176;
    transpose_tile(p.w_ff2 + (size_t)l * DFF * 1024, 1024, 1024, W2 + (size_t)l * 1024 * DFF, DFF, nullptr, 0, u / 4, u % 4, tile);
  }
  {
    const int gt = bid * 256 + tid, gn = G * 256;
    for (int i8 = gt; i8 < 2 * 2 * 4 * 2 * 512 * 32 / 8; i8 += gn) {
      const int i = i8 * 8, d = i & 31, pp = (i >> 5) & 511, m = (i >> 14) & 1, hd = (i >> 15) & 3, l = (i >> 17) & 1, b = i >> 18;
      const f32x4 x0 = *(const f32x4*)(p.cache_k + i), x1 = *(const f32x4*)(p.cache_k + i + 4);
      u32x4 o = {pack2(x0[0], x0[1]), pack2(x0[2], x0[3]), pack2(x1[0], x1[1]), pack2(x1[2], x1[3])};
      *(u32x4*)(DKS + (size_t)l * N_DKS + ((((size_t)b * 4 + hd) * 2 + m) * 2560 + 2048 + pp) * 32 + d) = o;
    }
    for (int i8 = gt; i8 < 2 * 2 * 4 * 64 * 512 / 8; i8 += gn) {
      const int p8 = (i8 & 63) * 8, dv = (i8 >> 6) & 63, hd = (i8 >> 12) & 3, l = (i8 >> 14) & 1, b = i8 >> 15;
      const float* sp = p.cache_v + ((((size_t)b * 2 + l) * 4 + hd) * 512 + p8) * 64 + dv;
      float x[8];
#pragma unroll
      for (int j = 0; j < 8; ++j) x[j] = sp[j * 64];
      u32x4 o = {pack2(x[0], x[1]), pack2(x[2], x[3]), pack2(x[4], x[5]), pack2(x[6], x[7])};
      *(u32x4*)(DVTS + (size_t)l * N_DVTS + (((size_t)b * 4 + hd) * 64 + dv) * 2560 + 2048 + p8) = o;
    }
    for (int i8 = gt; i8 < 2 * 2 * 512 * 256 / 8; i8 += gn) {
      const int i = i8 * 8, cc = i & 255, pp = (i >> 8) & 511, l = (i >> 17) & 1, b = i >> 18;
      const f32x4 x0 = *(const f32x4*)(p.cache_ckv + i), x1 = *(const f32x4*)(p.cache_ckv + i + 4);
      u32x4 o = {pack2(x0[0], x0[1]), pack2(x0[2], x0[3]), pack2(x1[0], x1[1]), pack2(x1[2], x1[3])};
      *(u32x4*)(CKVC + (((size_t)l * 2 + b) * 512 + pp) * 256 + cc) = o;
    }
    for (int i8 = gt; i8 < 2 * 2 * 512 * 32 / 8; i8 += gn) {
      const int j = i8 * 8, d = j & 31, pp = (j >> 5) & 511, l = (j >> 14) & 1, b = j >> 15;
      const f32x4 x0 = *(const f32x4*)(p.cache_kpe + j), x1 = *(const f32x4*)(p.cache_kpe + j + 4);
      u32x4 o = {pack2(x0[0], x0[1]), pack2(x0[2], x0[3]), pack2(x1[0], x1[1]), pack2(x1[2], x1[3])};
      for (int hh = 0; hh < 8; ++hh) *(u32x4*)(KMS + (size_t)l * N_KMS + (((size_t)b * 8 + hh) * 2560 + 2048 + pp) * 96 + 64 + d) = o;
    }
  }
  for (int c = (G >= 144 ? bid - (G - 144) : bid); c < 144; c += G) if (c >= 0) adaln_reduce(p, c, (const float*)(ws + O_PART), MOD, (unsigned*)(CTR + 4), rep);
  GSYNC();
  }
  for (int rep = 0; rep < REP_SYNC; ++rep) GSYNC();

  ln_mod_pass<false>(p.x_prompt, p.x_sample, nullptr, H, nullptr, nullptr, MOD);
  GSYNC();

  for (int l = 0; l < 2; ++l) {
    const float* MODl = MOD + (size_t)l * 3 * 6144;
    float* SSQl = (float*)(ws + O_SSQ) + (size_t)l * 2 * 8192;
    bf16_t* DKSl = DKS + (size_t)l * N_DKS; bf16_t* DVTSl = DVTS + (size_t)l * N_DVTS; bf16_t* KMSl = KMS + (size_t)l * N_KMS; bf16_t* VMTSl = VMTS + (size_t)l * N_VMTS;
    for (int rep = 0; rep < REP_P1; ++rep) {
      EpiIn e{l, AX, DQ, DKP, DKSl, DVTP, DVTSl, CQ, CKVB, KMP, KMSl, CKVF, p.out, SSQl};
      const bf16_t* Bt = WIN + (size_t)l * INP * 1024;
      gemm_phase(H, 1024, Bt, 1024, 1024, (bid & 7) * 8, bid >> 3, 8 * 18, G >> 3, smem, e);
      if (l == 0 && rep == 0) {
        const int per = G >> 3, xq = bid >> 3, nt_x = 8 * 18, first = nt_x % per;
        const int nlight = per - first;
        for (int t = (xq - first) * 8 + (bid & 7); xq >= first && t < 128; t += nlight * 8) {
          const int mt = t >> 3, ntile = t & 7, lc = mt >> 3;
          EpiUkv e2{1, nullptr, nullptr, KMS, VMTS, nullptr};
          if (__builtin_amdgcn_readfirstlane(tid >> 7)) gemm_tile<1>(CKVC, 256, WUKVC + (size_t)lc * 1024 * 256, 256, 256, mt * 128, ntile * 128, smem, e2);
          else gemm_tile<0>(CKVC, 256, WUKVC + (size_t)lc * 1024 * 256, 256, 256, mt * 128, ntile * 128, smem, e2);
        }
      }
      GSYNC();
    }
#ifdef PROBE_P1NULL
    {
      EpiInT<PROBE_P1NULL> e{l, AX, DQ, DKP, DKSl, DVTP, DVTSl, CQ, CKVB, KMP, KMSl, CKVF, p.out, SSQl};
      const bf16_t* Bt = WIN + (size_t)l * INP * 1024;
      for (int t = bid; t < 64 * 18; t += G) gemm_tile(H, 1024, Bt, 1024, 1024, (t / 18) * 128, (t % 18) * 128, smem, e);
      GSYNC();
    }
#endif
    for (int rep = 0; rep < REP_P2; ++rep) {
    for (int j = bid >> 3; j < 8 * 14; j += G >> 3) {
      const int mt = (bid & 7) * 8 + (j & 7), nn = j >> 3;
      if (nn < 6) {
        EpiUq e{QM, SSQl};
        gemm_tile(CQ, 384, WUQ + (size_t)l * 768 * 384, 384, 384, mt * 128, nn * 128, smem, e);
      } else {
        const int ntile = nn - 6;
        if (ntile == 0 && mt < 32) {
          const float* kw = p.kv_norm_w + l * 256;
          for (int i = tid; i < 128 * 64; i += 256) {
            const int row = i >> 6, c4 = (i & 63) * 4, T = mt * 128 + row, b = T >> 8, s = T & 255;
            const float rsv = rsqrtf(SSQl[8192 + T] * (1.f / 256.f) + 1e-6f);
            const f32x4 v = *(const f32x4*)(CKVF + (size_t)T * 256 + c4), wv = *(const f32x4*)(kw + c4);
            *(f32x4*)(p.out + OUT_CKV + (((size_t)b * 2 + l) * 256 + s) * 256 + c4) = v * rsv * wv;
          }
        }
        EpiUkv e{0, KMP, VMTP, KMSl, VMTSl, SSQl + 8192};
        if (__builtin_amdgcn_readfirstlane(tid >> 7)) gemm_tile<1>(CKVB, 256, WUKVN + (size_t)l * 1024 * 256, 256, 256, mt * 128, ntile * 128, smem, e);
        else gemm_tile<0>(CKVB, 256, WUKVN + (size_t)l * 1024 * 256, 256, 256, mt * 128, ntile * 128, smem, e);
      }
    }
    {
      asm volatile("" : "+v"(tid));
      const float* cw = p.conv_w + l * 768;
      for (int i = bid * 256 + tid; i < NTOK * 32; i += G * 256) {
        const int T = i >> 5, c = (i & 31) * 8;
        bool smp; int b, s; tok_decode(T, smp, b, s);
        const int slen = smp ? 2048 : 256;
        const bf16_t* row = AX + (size_t)T * 768;
        float u0[8], u1[8], u2[8], bb[8];
        {
          const u32x4 x = *(const u32x4*)(row + c), cc = *(const u32x4*)(row + 512 + c), bv = *(const u32x4*)(row + 256 + c);
#pragma unroll
          for (int j = 0; j < 4; ++j) {
            u1[2 * j] = __uint_as_float(x[j] << 16) * __uint_as_float(cc[j] << 16); u1[2 * j + 1] = __uint_as_float(x[j] & 0xffff0000u) * __uint_as_float(cc[j] & 0xffff0000u);
            bb[2 * j] = __uint_as_float(bv[j] << 16); bb[2 * j + 1] = __uint_as_float(bv[j] & 0xffff0000u);
          }
        }
        if (s > 0) {
          const u32x4 x = *(const u32x4*)(row - 768 + c), cc = *(const u32x4*)(row - 768 + 512 + c);
#pragma unroll
          for (int j = 0; j < 4; ++j) { u0[2 * j] = __uint_as_float(x[j] << 16) * __uint_as_float(cc[j] << 16); u0[2 * j + 1] = __uint_as_float(x[j] & 0xffff0000u) * __uint_as_float(cc[j] & 0xffff0000u); }
        } else {
#pragma unroll
          for (int j = 0; j < 8; ++j) u0[j] = 0.f;
        }
        if (s < slen - 1) {
          const u32x4 x = *(const u32x4*)(row + 768 + c), cc = *(const u32x4*)(row + 768 + 512 + c);
#pragma unroll
          for (int j = 0; j < 4; ++j) { u2[2 * j] = __uint_as_float(x[j] << 16) * __uint_as_float(cc[j] << 16); u2[2 * j + 1] = __uint_as_float(x[j] & 0xffff0000u) * __uint_as_float(cc[j] & 0xffff0000u); }
        } else {
#pragma unroll
          for (int j = 0; j < 8; ++j) u2[j] = 0.f;
        }
        float o[8];
#pragma unroll
        for (int q = 0; q < 2; ++q) {
          const f32x4 w0 = *(const f32x4*)(cw + c + 4 * q), w1 = *(const f32x4*)(cw + 256 + c + 4 * q), w2 = *(const f32x4*)(cw + 512 + c + 4 * q);
#pragma unroll
          for (int j = 0; j < 4; ++j) o[4 * q + j] = bb[4 * q + j] * (u0[4 * q + j] * w0[j] + u1[4 * q + j] * w1[j] + u2[4 * q + j] * w2[j]);
        }
        u32x4 ov = {pack2(o[0], o[1]), pack2(o[2], o[3]), pack2(o[4], o[5]), pack2(o[6], o[7])};
        *(u32x4*)(Y + (size_t)T * 1024 + c) = ov;
      }
    }
    GSYNC();
    }
    for (int rep = 0; rep < REP_P3; ++rep) {
      const float lam_init = l == 0 ? 0.2f : 0.8f - 0.6f * 0.7408182206817179f;
      float d1 = 0.f, d2 = 0.f;
      for (int j = 0; j < 32; ++j) { d1 += p.lq1[l * 32 + j] * p.lk1[l * 32 + j]; d2 += p.lq2[l * 32 + j] * p.lk2[l * 32 + j]; }
      const float lam = expf(d1) - expf(d2) + lam_init;
      const float* nw = p.diff_norm_w + l * 64;
      for (;;) {
        __syncthreads();
        if (tid == 0) s_unit = atomicAdd(CTR + 16 + (l + 2 * rep) * 8 + (bid & 7), 1);
        __syncthreads();
        const int vq = __builtin_amdgcn_readfirstlane(s_unit);
        if (vq >= 112) break;
        int u;
        {
          const int x = bid & 7;
          if (vq < 32) u = (2 * x + (vq >> 4)) * 16 + (vq & 15);
          else if (vq < 64) { const int v1 = vq - 32; u = 256 + (x * 16 + (v1 & 15)) * 2 + (v1 >> 4); }
          else if (vq < 96) { const int v1 = vq - 64; u = 512 + (16 * x + (v1 >> 1)) * 2 + (v1 & 1); }
          else { const int v1 = vq - 96; u = 768 + (8 * x + (v1 >> 1)) * 2 + (v1 & 1); }
        }
        const bf16_t *Qp, *Kp, *VTp; bf16_t* Yp; int S_all, mode, mapidx = 0, pairid = 0;
        if (u < 256) {
          const int b = u >> 7, hh = (u >> 4) & 7, qb = u & 15; mode = 0; S_all = 2560;
          Qp = QM + (size_t)NPR * 768 + (((size_t)b * 8 + hh) * 2048 + qb * 128) * 96; Kp = KMSl + ((size_t)b * 8 + hh) * 2560 * 96; VTp = VMTSl + ((size_t)b * 8 + hh) * 64 * 2560;
          Yp = Y + (size_t)(NPR + b * 2048 + qb * 128) * 1024 + 512 + hh * 64;
        } else if (u < 512) {
          const int v2 = u - 256; pairid = v2 >> 1; mapidx = v2 & 1;
          const int b = pairid >> 6, hd = (pairid >> 4) & 3, qb = pairid & 15; mode = 2; S_all = 2560;
          Qp = DQ + (size_t)NPR * 256 + ((((size_t)b * 4 + hd) * 2 + mapidx) * 2048 + qb * 128) * 32; Kp = DKSl + (((size_t)b * 4 + hd) * 2 + mapidx) * 2560 * 32; VTp = DVTSl + ((size_t)b * 4 + hd) * 64 * 2560;
          Yp = Y + (size_t)(NPR + b * 2048 + qb * 128) * 1024 + 256 + hd * 64;
        } else if (u < 768) {
          const int v = u - 512, b = v >> 4, hh = (v >> 1) & 7, qb = v & 1; mode = 0; S_all = 256;
          Qp = QM + (((size_t)b * 8 + hh) * 256 + qb * 128) * 96; Kp = KMP + ((size_t)b * 8 + hh) * 256 * 96; VTp = VMTP + ((size_t)b * 8 + hh) * 64 * 256;
          Yp = Y + (size_t)(b * 256 + qb * 128) * 1024 + 512 + hh * 64;
        } else {
          const int v = u - 768, b = v >> 3, hd = (v >> 1) & 3, qb = v & 1; mode = 1; S_all = 256;
          Qp = DQ + ((((size_t)b * 4 + hd) * 2) * 256 + qb * 128) * 32; Kp = DKP + (((size_t)b * 4 + hd) * 2) * 256 * 32; VTp = DVTP + ((size_t)b * 4 + hd) * 64 * 256;
          Yp = Y + (size_t)(b * 256 + qb * 128) * 1024 + 256 + hd * 64;
        }
        float* owsp = (float*)(ws + O_OWS) + ((size_t)(l * 128 + pairid) * 2) * 128 * 64;
        unsigned* flg = (unsigned*)(ws + O_FLG) + l * 128 + pairid + 256 * rep;
        if (mode == 1) attn_unit<1>(Qp, (size_t)256 * 32, Kp, (size_t)256 * 32, VTp, S_all, S_all, Yp, lam, nw, 1.f - lam_init, smem, nullptr, nullptr, 0, &s_flag);
        else if (mode == 2) attn_unit<2>(Qp, 0, Kp, 0, VTp, S_all, S_all, Yp, lam, nw, 1.f - lam_init, smem, owsp, flg, mapidx, &s_flag);
        else attn_unit<0>(Qp, 0, Kp, 0, VTp, S_all, S_all, Yp, 0.f, nw, 1.f, smem, nullptr, nullptr, 0, &s_flag);
      }
      GSYNC();
    }
    if (l == 0)
    {
      EpiResLN<0, 1> e{l == 0 ? p.x_prompt : XZ, l == 0 ? p.x_sample : XZ + (size_t)NPR * 1024, XZ, H, MODl + 2 * 1024, p.ln1_g + l * 1024, p.ln1_b + l * 1024, MODl + 3 * 1024,
                 (unsigned long long*)(ws + O_EXCH) + (size_t)(l * 2 + 0) * 64 * 8 * 128, (unsigned*)(ws + O_LNC) + (size_t)(l * 2 + 0) * 64 * 64, smem, 0, 0};
      const bf16_t* Bt = WOUT + (size_t)l * 1024 * 1024;
      for (int j = bid >> 3; j < 8 * 8; j += G >> 3) { e.mt = (bid & 7) * 8 + (j >> 3); e.nt = j & 7; gemm_tile(Y, 1024, Bt, 1024, 1024, e.mt * 128, e.nt * 128, smem, e); }
    }
    else
    {
      EpiResLN<1, 1> e{l == 0 ? p.x_prompt : XZ, l == 0 ? p.x_sample : XZ + (size_t)NPR * 1024, XZ, H, MODl + 2 * 1024, p.ln1_g + l * 1024, p.ln1_b + l * 1024, MODl + 3 * 1024,
                 (unsigned long long*)(ws + O_EXCH) + (size_t)(l * 2 + 0) * 64 * 8 * 128, (unsigned*)(ws + O_LNC) + (size_t)(l * 2 + 0) * 64 * 64, smem, 0, 0};
      const bf16_t* Bt = WOUT + (size_t)l * 1024 * 1024;
      for (int j = bid >> 3; j < 8 * 8; j += G >> 3) { e.mt = (bid & 7) * 8 + (j >> 3); e.nt = j & 7; gemm_tile(Y, 1024, Bt, 1024, 1024, e.mt * 128, e.nt * 128, smem, e); }
    }
    GSYNC();
#ifdef PROBE_BD
    {
      EpiFfUp e{ACT};
      const bf16_t* Bt = W13 + (size_t)l * 5632 * 1024;
      for (int j = bid >> 3; j < 8 * 44; j += G >> 3) gemm_tile_bd(H, 1024, Bt, 1024, ((bid & 7) * 8 + (j & 7)) * 128, (j >> 3) * 128, smem, e);
      GSYNC();
    }
#endif
    for (int rep = 0; rep < REP_P6; ++rep) {
      EpiFfUp e{ACT};
      const bf16_t* Bt = W13 + (size_t)l * 5632 * 1024;
      gemm_phase(H, 1024, Bt, 1024, 1024, (bid & 7) * 8, bid >> 3, 8 * 44, G >> 3, smem, e);
      GSYNC();
    }
    if (l == 0)
    {
      EpiResLN<1, 1> e{XZ, XZ + (size_t)NPR * 1024, l == 0 ? XZ : p.out + OUT_Y, l == 0 ? H : nullptr, MODl + 5 * 1024, p.ln2_g + l * 1024, p.ln2_b + l * 1024, MOD + (size_t)3 * 6144,
                 (unsigned long long*)(ws + O_EXCH) + (size_t)(l * 2 + 1) * 64 * 8 * 128, (unsigned*)(ws + O_LNC) + (size_t)(l * 2 + 1) * 64 * 64, smem, 0, 0};
      const bf16_t* Bt = W2 + (size_t)l * 1024 * DFF;
      for (int j = bid >> 3; j < 8 * 8; j += G >> 3) { e.mt = (bid & 7) * 8 + (j >> 3); e.nt = j & 7; gemm_tile(ACT, DFF, Bt, DFF, DFF, e.mt * 128, e.nt * 128, smem, e); }
    }
    else
    {
      EpiResLN<1, 0> e{XZ, XZ + (size_t)NPR * 1024, l == 0 ? XZ : p.out + OUT_Y, l == 0 ? H : nullptr, MODl + 5 * 1024, p.ln2_g + l * 1024, p.ln2_b + l * 1024, MOD + (size_t)3 * 6144,
                 (unsigned long long*)(ws + O_EXCH) + (size_t)(l * 2 + 1) * 64 * 8 * 128, (unsigned*)(ws + O_LNC) + (size_t)(l * 2 + 1) * 64 * 64, smem, 0, 0};
      const bf16_t* Bt = W2 + (size_t)l * 1024 * DFF;
      for (int j = bid >> 3; j < 8 * 8; j += G >> 3) { e.mt = (bid & 7) * 8 + (j >> 3); e.nt = j & 7; gemm_tile(ACT, DFF, Bt, DFF, DFF, e.mt * 128, e.nt * 128, smem, e); }
    }
    if (l == 0) GSYNC();
  }
}

extern "C" void kernel_launch(void* const* d_in, const int* in_sizes, int n_in, void* d_out, int out_size, void* d_ws, size_t ws_size, hipStream_t stream) {
  static int grid_blocks = 0;
  if (!grid_blocks) {
    int dev = 0, cus = 0, per_cu = 0;
    hipGetDevice(&dev);
    hipDeviceGetAttribute(&cus, hipDeviceAttributeMultiprocessorCount, dev);
    hipOccupancyMaxActiveBlocksPerMultiprocessor(&per_cu, mega, 256, 0);
    if (per_cu > 2) per_cu = 2;
    if (per_cu < 1) per_cu = 1;
    grid_blocks = (cus * per_cu) & ~7;
  }
  if (ws_size < WS_NEED) { fprintf(stderr, "workspace too small: %zu < %zu\n", ws_size, (size_t)WS_NEED); return; }
  Params p{};
  const float** pp = (const float**)&p;
  for (int i = 0; i < 29; ++i) pp[i] = (const float*)d_in[i];
  p.out = (float*)d_out; p.ws = (char*)d_ws;
  hipMemsetAsync((char*)d_ws + O_CTR, 0, O_OVL - O_CTR, stream);
  void* args[] = {&p};
  hipError_t e = hipLaunchCooperativeKernel((void*)mega, dim3(grid_blocks), dim3(256), args, 0, stream);
  if (e != hipSuccess) fprintf(stderr, "cooperative launch failed: %s (grid %d)\n", hipGetErrorString(e), grid_blocks);
}
```
